# Optimizing an MI355X kernel written in HIP

```python
import math
import jax, jax.numpy as jnp
from jax import lax
import numpy as np

D_MODEL = 2048
BATCH = 1
SEQ = 8192
DEPTH = 1

PLE_DIM = 256
EPS = 1e-6
SSM_WIDTH = D_MODEL // 2
SSM_GROUP = 16
SSM_GROUPS = SSM_WIDTH // SSM_GROUP
SSM_STATE = 64
DT_MIN = 1e-3
DT_MAX = 1e-1
N_HEADS = 8
N_KV_HEADS = 2
HEAD_DIM = 128
ATTN_WIDTH = N_HEADS * HEAD_DIM
Q_LORA_RANK = 512
IDX_HEADS = 16
IDX_DIM = 64
TOPK_MAX = 256
Q_BLOCK = 128
IN_SIZES = (SSM_WIDTH, SSM_WIDTH, Q_LORA_RANK, N_KV_HEADS * HEAD_DIM, N_KV_HEADS * HEAD_DIM,
            ATTN_WIDTH, IDX_DIM, IDX_HEADS, D_MODEL, D_MODEL)
IN_WIDTH = sum(IN_SIZES)

kernel_name = "hybrid_s5_dsa_gated_block"


def rms_norm(x, g):
    x32 = x.astype(jnp.float32)
    y = x32 * lax.rsqrt(jnp.mean(x32 * x32, axis=-1, keepdims=True) + EPS)
    return y.astype(x.dtype) * g


def split_points():
    pts, acc = [], 0
    for s in IN_SIZES[:-1]:
        acc += s
        pts.append(acc)
    return pts


def s5_branch(u, a_re, a_im, log_dt, b_re, b_im, c_re, c_im, d_skip, w_glu):
    bsz, seq, _ = u.shape
    f32 = jnp.float32
    uf = u.astype(f32).reshape(bsz, seq, SSM_GROUPS, SSM_GROUP)
    dt = jnp.exp(log_dt.astype(f32))[:, None]
    ar, ai = a_re.astype(f32), a_im.astype(f32)
    mag = jnp.exp(dt * ar)
    abar_re = mag * jnp.cos(dt * ai)
    abar_im = mag * jnp.sin(dt * ai)
    den = ar * ar + ai * ai
    nr = abar_re - 1.0
    f_re = (nr * ar + abar_im * ai) / den
    f_im = (abar_im * ar - nr * ai) / den
    br, bi = b_re.astype(f32), b_im.astype(f32)
    bb_re = f_re[..., None] * br - f_im[..., None] * bi
    bb_im = f_re[..., None] * bi + f_im[..., None] * br
    bu_re = jnp.einsum('bsgc,gnc->bsgn', uf, bb_re)
    bu_im = jnp.einsum('bsgc,gnc->bsgn', uf, bb_im)
    at_re = jnp.broadcast_to(abar_re, bu_re.shape)
    at_im = jnp.broadcast_to(abar_im, bu_im.shape)

    def combine(e1, e2):
        a1r, a1i, x1r, x1i = e1
        a2r, a2i, x2r, x2i = e2
        return (a1r * a2r - a1i * a2i,
                a1r * a2i + a1i * a2r,
                a2r * x1r - a2i * x1i + x2r,
                a2r * x1i + a2i * x1r + x2i)

    _, _, h_re, h_im = lax.associative_scan(combine, (at_re, at_im, bu_re, bu_im), axis=1)
    y = (jnp.einsum('bsgn,gcn->bsgc', h_re, c_re.astype(f32))
         - jnp.einsum('bsgn,gcn->bsgc', h_im, c_im.astype(f32))
         + d_skip.astype(f32).reshape(SSM_GROUPS, SSM_GROUP) * uf)
    y = jax.nn.gelu(y.reshape(bsz, seq, SSM_WIDTH))
    a, b = jnp.split(y @ w_glu.astype(f32), 2, axis=-1)
    return (a * jax.nn.sigmoid(b)).astype(u.dtype)


def dsa_branch(q, k, v, q_idx, k_idx, w_idx):
    bsz, seq = q.shape[0], q.shape[1]
    n_keys = k.shape[1]
    topk = min(TOPK_MAX, n_keys // 4)
    n_blocks = seq // Q_BLOCK
    rep = N_HEADS // N_KV_HEADS
    key_pos = jnp.arange(n_keys)
    gather = jax.vmap(lambda arr, ii: arr[ii])

    def block(j):
        start = j * Q_BLOCK
        qb = lax.dynamic_slice_in_dim(q, start, Q_BLOCK, axis=1)
        qib = lax.dynamic_slice_in_dim(q_idx, start, Q_BLOCK, axis=1)
        wb = lax.dynamic_slice_in_dim(w_idx, start, Q_BLOCK, axis=1)
        t = start + jnp.arange(Q_BLOCK)
        raw = jax.nn.relu(jnp.einsum('bqhd,bsd->bqhs', qib, k_idx))
        score = jnp.einsum('bqhs,bqh->bqs', raw, wb).astype(jnp.float32)
        causal = key_pos[None, :] <= t[:, None]
        score = jnp.where(causal[None], score, -jnp.inf)
        vals, idx = lax.top_k(score, topk)
        valid = jnp.isfinite(vals)
        ks = gather(k, idx)
        vs = gather(v, idx)
        qg = qb.reshape(bsz, Q_BLOCK, N_KV_HEADS, rep, HEAD_DIM)
        logits = jnp.einsum('bqgrd,bqngd->bqgrn', qg, ks).astype(jnp.float32) * (HEAD_DIM ** -0.5)
        logits = jnp.where(valid[:, :, None, None, :], logits, -jnp.inf)
        probs = jax.nn.softmax(logits, axis=-1).astype(v.dtype)
        o = jnp.einsum('bqgrn,bqngd->bqgrd', probs, vs)
        return o.reshape(bsz, Q_BLOCK, ATTN_WIDTH)

    out = lax.map(block, jnp.arange(n_blocks))
    return out.transpose(1, 0, 2, 3).reshape(bsz, seq, ATTN_WIDTH)


def setup_inputs(seed: int = 0) -> dict:
    key = jax.random.key(seed)
    ks = jax.random.split(key, 32)
    f32 = jnp.float32

    def nrm(k, shape, scale):
        return jax.random.normal(k, shape, f32) * scale

    def gain(k, shape):
        return 1.0 + 0.02 * jax.random.normal(k, shape, f32)

    L = DEPTH
    n = jnp.arange(SSM_STATE, dtype=f32)
    a_re = -0.5 + 0.01 * jax.random.normal(ks[8], (L, SSM_GROUPS, SSM_STATE), f32)
    a_im = math.pi * n + 0.01 * jax.random.normal(ks[9], (L, SSM_GROUPS, SSM_STATE), f32)
    log_dt = jax.random.uniform(ks[10], (L, SSM_GROUPS), f32, math.log(DT_MIN), math.log(DT_MAX))
    b_scale = (2.0 * SSM_GROUP) ** -0.5
    c_scale = (2.0 * SSM_STATE) ** -0.5
    return {
        "x": jax.random.normal(ks[0], (BATCH, SEQ, D_MODEL), f32),
        "p": jax.random.normal(ks[1], (DEPTH, BATCH, SEQ, PLE_DIM), f32),
        "g_mix": gain(ks[2], (L, D_MODEL)),
        "w_in": nrm(ks[3], (L, D_MODEL, IN_WIDTH), D_MODEL ** -0.5),
        "g_q": gain(ks[4], (L, Q_LORA_RANK)),
        "w_uq": nrm(ks[5], (L, Q_LORA_RANK, ATTN_WIDTH), Q_LORA_RANK ** -0.5),
        "w_uq_idx": nrm(ks[6], (L, Q_LORA_RANK, IDX_HEADS * IDX_DIM), Q_LORA_RANK ** -0.5),
        "g_kidx": gain(ks[7], (L, IDX_DIM)),
        "a_re": a_re,
        "a_im": a_im,
        "log_dt": log_dt,
        "b_re": nrm(ks[11], (L, SSM_GROUPS, SSM_STATE, SSM_GROUP), b_scale),
        "b_im": nrm(ks[12], (L, SSM_GROUPS, SSM_STATE, SSM_GROUP), b_scale),
        "c_re": nrm(ks[13], (L, SSM_GROUPS, SSM_GROUP, SSM_STATE), c_scale),
        "c_im": nrm(ks[14], (L, SSM_GROUPS, SSM_GROUP, SSM_STATE), c_scale),
        "d_skip": nrm(ks[15], (L, SSM_WIDTH), 1.0),
        "w_glu": nrm(ks[16], (L, SSM_WIDTH, 2 * SSM_WIDTH), SSM_WIDTH ** -0.5),
        "w_ssm_out": nrm(ks[17], (L, SSM_WIDTH, D_MODEL), SSM_WIDTH ** -0.5),
        "w_attn_out": nrm(ks[18], (L, ATTN_WIDTH, D_MODEL), ATTN_WIDTH ** -0.5),
        "w_o": nrm(ks[19], (L, D_MODEL, D_MODEL), D_MODEL ** -0.5),
        "g_ple": gain(ks[20], (L, D_MODEL)),
        "w_ple_gate": nrm(ks[21], (L, D_MODEL, D_MODEL), D_MODEL ** -0.5),
        "w_ple": nrm(ks[22], (L, PLE_DIM, D_MODEL), PLE_DIM ** -0.5),
        "g_ple_post": gain(ks[23], (L, D_MODEL)),
        "g_final": gain(ks[24], (D_MODEL,)),
    }


def reference(x, p, g_mix, w_in, g_q, w_uq, w_uq_idx, g_kidx, a_re, a_im, log_dt, b_re, b_im,
              c_re, c_im, d_skip, w_glu, w_ssm_out, w_attn_out, w_o, g_ple, w_ple_gate, w_ple,
              g_ple_post, g_final):
    bsz, seq, _ = x.shape
    pts = split_points()
    for i in range(DEPTH):
        h = rms_norm(x, g_mix[i])
        proj = h @ w_in[i]
        (u, z_ssm, c_q, k, v, z_attn, k_idx, w_idx, gate_ssm, gate_attn) = jnp.split(proj, pts, axis=-1)

        y_ssm = s5_branch(u, a_re[i], a_im[i], log_dt[i], b_re[i], b_im[i], c_re[i], c_im[i],
                          d_skip[i], w_glu[i]) * jax.nn.silu(z_ssm)
        o_ssm = y_ssm @ w_ssm_out[i]

        cq = rms_norm(c_q, g_q[i])
        q = (cq @ w_uq[i]).reshape(bsz, seq, N_HEADS, HEAD_DIM)
        q_idx = (cq @ w_uq_idx[i]).reshape(bsz, seq, IDX_HEADS, IDX_DIM)
        k_idx = rms_norm(k_idx, g_kidx[i])
        w_idx = w_idx * ((IDX_HEADS ** -0.5) * (IDX_DIM ** -0.5))
        k = k.reshape(bsz, seq, N_KV_HEADS, HEAD_DIM)
        v = v.reshape(bsz, seq, N_KV_HEADS, HEAD_DIM)
        y_attn = dsa_branch(q, k, v, q_idx, k_idx, w_idx) * jax.nn.silu(z_attn)
        o_attn = y_attn @ w_attn_out[i]

        merged = jax.nn.sigmoid(gate_ssm) * o_ssm + jax.nn.sigmoid(gate_attn) * o_attn
        x = x + merged @ w_o[i]

        e = rms_norm(p[i] @ w_ple[i], g_ple_post[i])
        gate = jax.nn.sigmoid(rms_norm(x, g_ple[i]) @ w_ple_gate[i])
        x = x + gate * e
    return rms_norm(x, g_final)
```

```cpp
#include <hip/hip_runtime.h>
#include <hip/hip_cooperative_groups.h>
#include <stdint.h>
#include <stdio.h>
namespace cg = cooperative_groups;

#ifndef PROBE_DUP
#define PROBE_DUP -1
#endif
#ifndef PROBE_SEC
#define PROBE_SEC 0
#endif
#ifndef N_LAUNCH_MODE
#define N_LAUNCH_MODE 1
#endif

typedef unsigned short u16;
typedef short bf16x8 __attribute__((ext_vector_type(8)));
typedef float f32x16 __attribute__((ext_vector_type(16)));
typedef float f32x4 __attribute__((ext_vector_type(4)));

#define DEV __device__ __forceinline__
#define LDS_FENCE() asm volatile("s_waitcnt lgkmcnt(0)" ::: "memory")

constexpr int NPHASE = 9;
constexpr int LDS_BYTES = 70656;

constexpr size_t O_WIN = 0;
constexpr size_t O_YACT = 0;
constexpr size_t O_YATT = 16777216;
constexpr size_t O_WUQ = 34078720;
constexpr size_t O_WGLU = O_WUQ + 2097152;
constexpr size_t O_WSSMO = O_WGLU + 4194304;
constexpr size_t O_WATTO = O_WSSMO + 4194304;
constexpr size_t O_WO = O_WATTO + 4194304;
constexpr size_t O_WPG = O_WO + 8388608;
constexpr size_t O_WPLE = O_WPG + 8388608;
constexpr size_t O_H = O_WPLE + 1048576;
constexpr size_t O_Q = O_H;
constexpr size_t O_QIDX = O_H + 16777216;
constexpr size_t O_MERGED = O_H;
constexpr size_t O_U = O_H + 33554432;
constexpr size_t O_ZS = O_U + 16777216;
constexpr size_t O_X1B = O_U;
constexpr size_t O_CQ = O_ZS + 16777216;
constexpr size_t O_K = O_CQ + 8388608;
constexpr size_t O_V = O_K + 4194304;
constexpr size_t O_ZA = O_V + 4194304;
constexpr size_t O_GS = O_ZA + 16777216;
constexpr size_t O_GA = O_GS + 33554432;
constexpr size_t O_KIDXRAW = O_GA + 33554432;
constexpr size_t O_KIDX = O_KIDXRAW + 2097152;
constexpr size_t O_WIDX = O_KIDX + 1048576;
constexpr size_t O_PBF = O_WIDX + 524288;
constexpr size_t O_ABAR = O_PBF + 4194304;
constexpr size_t O_ABART = O_ABAR + 32768;
constexpr size_t O_BBT = O_ABART + 32768;
constexpr size_t O_CCT = O_BBT + 262144;
constexpr size_t O_ENDST = O_CCT + 524288;
constexpr size_t O_SSQ1 = O_ENDST + 1048576;
constexpr size_t O_SSQE = O_SSQ1 + 1048576;
constexpr size_t O_SSQC = O_SSQE + 1048576;
constexpr size_t O_BAR = O_SSQC + 131072;
constexpr size_t WS_END = O_BAR + 16384;

struct Params {
    const float *x, *p, *g_mix, *w_in, *g_q, *w_uq, *w_uq_idx, *g_kidx, *a_re, *a_im, *log_dt, *b_re, *b_im,
        *c_re, *c_im, *d_skip, *w_glu, *w_ssm_out, *w_attn_out, *w_o, *g_ple, *w_ple_gate, *w_ple, *g_ple_post, *g_final;
    float* out;
    unsigned char* ws;
    int ph_lo, ph_hi;
};

DEV u16 f2bf(float f) { uint32_t u = __float_as_uint(f); u += 0x7FFFu + ((u >> 16) & 1u); return (u16)(u >> 16); }
DEV float bf2f(u16 h) { return __uint_as_float(((uint32_t)h) << 16); }
DEV uint32_t pack2(float a, float b) { return (uint32_t)f2bf(a) | ((uint32_t)f2bf(b) << 16); }
DEV float sigmoidf_(float x) { return 1.f / (1.f + __expf(-x)); }
DEV float siluf_(float x) { return x / (1.f + __expf(-x)); }
DEV float geluf_(float x) { float u = 0.7978845608028654f * (x + 0.044715f * x * x * x); return x - x / (1.f + __expf(2.f * u)); }
DEV float wave_sum(float v) { for (int d = 32; d >= 1; d >>= 1) v += __shfl_xor(v, d); return v; }
#define DPPF_(v, ctrl) __int_as_float(__builtin_amdgcn_mov_dpp(__float_as_int(v), ctrl, 0xF, 0xF, true))
DEV float wave_max_fast(float v) {
    v = fmaxf(v, DPPF_(v, 0xB1)); v = fmaxf(v, DPPF_(v, 0x4E)); v = fmaxf(v, DPPF_(v, 0x141)); v = fmaxf(v, DPPF_(v, 0x140));
    const float r0 = __int_as_float(__builtin_amdgcn_readlane(__float_as_int(v), 0)), r1 = __int_as_float(__builtin_amdgcn_readlane(__float_as_int(v), 16));
    const float r2 = __int_as_float(__builtin_amdgcn_readlane(__float_as_int(v), 32)), r3 = __int_as_float(__builtin_amdgcn_readlane(__float_as_int(v), 48));
    return fmaxf(fmaxf(r0, r1), fmaxf(r2, r3));
}
DEV float wave_sum_fast(float v) {
    v += DPPF_(v, 0xB1); v += DPPF_(v, 0x4E); v += DPPF_(v, 0x141); v += DPPF_(v, 0x140);
    const float r0 = __int_as_float(__builtin_amdgcn_readlane(__float_as_int(v), 0)), r1 = __int_as_float(__builtin_amdgcn_readlane(__float_as_int(v), 16));
    const float r2 = __int_as_float(__builtin_amdgcn_readlane(__float_as_int(v), 32)), r3 = __int_as_float(__builtin_amdgcn_readlane(__float_as_int(v), 48));
    return (r0 + r1) + (r2 + r3);
}
DEV float wave_max(float v) { for (int d = 32; d >= 1; d >>= 1) v = fmaxf(v, __shfl_xor(v, d)); return v; }

DEV void gemm_mainloop(const u16* __restrict__ A, int lda, const u16* __restrict__ B, int ldb, int K,
                       unsigned char* smem, f32x16 (&acc)[2][2]) {
    const int tid = threadIdx.x, lane = tid & 63, wid = tid >> 6;
    const int wm = wid >> 1, wn = wid & 1;
    const int lrow = tid >> 3, lslot = tid & 7;
    uint4 pa0, pa1, pa2, pa3, pb0, pb1, pb2, pb3;
    uint4 qa0, qa1, qa2, qa3, qb0, qb1, qb2, qb3;
    const u16* Ap = A + (size_t)lrow * lda + lslot * 8;
    const u16* Bp = B + (size_t)lrow * ldb + lslot * 8;
    const size_t a32 = (size_t)32 * lda, b32 = (size_t)32 * ldb;
    const int woff = lrow * 128 + ((lslot ^ ((lrow >> 1) & 7)) << 4);
#define GLOAD(S, k0) { S##a0 = *(const uint4*)(Ap + (k0)); S##a1 = *(const uint4*)(Ap + a32 + (k0)); S##a2 = *(const uint4*)(Ap + 2 * a32 + (k0)); S##a3 = *(const uint4*)(Ap + 3 * a32 + (k0)); \
                       S##b0 = *(const uint4*)(Bp + (k0)); S##b1 = *(const uint4*)(Bp + b32 + (k0)); S##b2 = *(const uint4*)(Bp + 2 * b32 + (k0)); S##b3 = *(const uint4*)(Bp + 3 * b32 + (k0)); }
#define SWRITE(S, buf) { unsigned char* as_ = smem + (buf) * 16384 + woff; unsigned char* bs_ = smem + 32768 + (buf) * 16384 + woff; \
                      *(uint4*)(as_) = S##a0; *(uint4*)(as_ + 4096) = S##a1; *(uint4*)(as_ + 8192) = S##a2; *(uint4*)(as_ + 12288) = S##a3; \
                      *(uint4*)(bs_) = S##b0; *(uint4*)(bs_ + 4096) = S##b1; *(uint4*)(bs_ + 8192) = S##b2; *(uint4*)(bs_ + 12288) = S##b3; }
    const int nk = K >> 6;
    const int rA = wm * 64 + (lane & 31), rB = wn * 64 + (lane & 31);
    const int swA = (rA >> 1) & 7, swB = (rB >> 1) & 7;
    const int h = lane >> 5;
#define FRAG(ks, a0, a1, b0, b1) const int slot##ks = (ks) * 2 + h; \
            const bf16x8 a0 = *(const bf16x8*)(as_ + ((slot##ks ^ swA) << 4)); const bf16x8 a1 = *(const bf16x8*)(as_ + 4096 + ((slot##ks ^ swA) << 4)); \
            const bf16x8 b0 = *(const bf16x8*)(bs_ + ((slot##ks ^ swB) << 4)); const bf16x8 b1 = *(const bf16x8*)(bs_ + 4096 + ((slot##ks ^ swB) << 4));
#define MM(a0, a1, b0, b1) acc[0][0] = __builtin_amdgcn_mfma_f32_32x32x16_bf16(a0, b0, acc[0][0], 0, 0, 0); acc[0][1] = __builtin_amdgcn_mfma_f32_32x32x16_bf16(a0, b1, acc[0][1], 0, 0, 0); \
            acc[1][0] = __builtin_amdgcn_mfma_f32_32x32x16_bf16(a1, b0, acc[1][0], 0, 0, 0); acc[1][1] = __builtin_amdgcn_mfma_f32_32x32x16_bf16(a1, b1, acc[1][1], 0, 0, 0);
#define COMPUTE(cur) { const unsigned char* as_ = smem + (cur) * 16384 + rA * 128; const unsigned char* bs_ = smem + 32768 + (cur) * 16384 + rB * 128; \
        FRAG(0, fa00, fa01, fb00, fb01) FRAG(1, fa10, fa11, fb10, fb11) FRAG(2, fa20, fa21, fb20, fb21) FRAG(3, fa30, fa31, fb30, fb31) \
        MM(fa00, fa01, fb00, fb01) MM(fa10, fa11, fb10, fb11) MM(fa20, fa21, fb20, fb21) MM(fa30, fa31, fb30, fb31) \
        __builtin_amdgcn_sched_group_barrier(0x100, 8, 0); __builtin_amdgcn_sched_group_barrier(0x008, 4, 0); \
        __builtin_amdgcn_sched_group_barrier(0x100, 4, 0); __builtin_amdgcn_sched_group_barrier(0x008, 4, 0); \
        __builtin_amdgcn_sched_group_barrier(0x100, 4, 0); __builtin_amdgcn_sched_group_barrier(0x008, 8, 0); }
    GLOAD(p, 0);
    GLOAD(q, 64);
    SWRITE(p, 0);
    __syncthreads();
    for (int kt = 0; kt < nk; kt += 2) {
        if (kt + 2 < nk) GLOAD(p, (kt + 2) * 64);
        COMPUTE(0);
        SWRITE(q, 1);
        __syncthreads();
        if (kt + 3 < nk) GLOAD(q, (kt + 3) * 64);
        COMPUTE(1);
        if (kt + 2 < nk) SWRITE(p, 0);
        __syncthreads();
    }
#undef GLOAD
#undef SWRITE
#undef COMPUTE
#undef FRAG
#undef MM
}

DEV void stage_half(const f32x16 (&acc)[2][2], int mi, float* st) {
    const int lane = threadIdx.x & 63, wid = threadIdx.x >> 6, wm = wid >> 1, wn = wid & 1;
#pragma unroll
    for (int ni = 0; ni < 2; ++ni)
#pragma unroll
        for (int r = 0; r < 16; ++r)
            st[(wm * 32 + (r & 3) + 8 * (r >> 2) + 4 * (lane >> 5)) * 132 + wn * 64 + ni * 32 + (lane & 31)] = mi ? acc[1][ni][r] : acc[0][ni][r];
    __syncthreads();
}
#define SR_TO_ROW(sr, mi) ((((sr) >> 5) << 6) + (mi) * 32 + ((sr) & 31))
typedef unsigned u32x4nt __attribute__((ext_vector_type(4)));
typedef float f32x4nt __attribute__((ext_vector_type(4)));
DEV void st_nt16(void* p, const uint4 v) { const u32x4nt t = {v.x, v.y, v.z, v.w}; __builtin_nontemporal_store(t, (u32x4nt*)p); }
DEV void st_nt16f(void* p, const float4 v) { const f32x4nt t = {v.x, v.y, v.z, v.w}; __builtin_nontemporal_store(t, (f32x4nt*)p); }
DEV float4 ld_nt16f(const void* p) { const f32x4nt t = __builtin_nontemporal_load((const f32x4nt*)p); return make_float4(t[0], t[1], t[2], t[3]); }
DEV uint4 pack8(const float (&v)[8]) { uint4 o; o.x = pack2(v[0], v[1]); o.y = pack2(v[2], v[3]); o.z = pack2(v[4], v[5]); o.w = pack2(v[6], v[7]); return o; }
DEV void unpack8(const uint4 q, float (&v)[8]) {
    v[0] = __uint_as_float(q.x << 16); v[1] = __uint_as_float(q.x & 0xFFFF0000u); v[2] = __uint_as_float(q.y << 16); v[3] = __uint_as_float(q.y & 0xFFFF0000u);
    v[4] = __uint_as_float(q.z << 16); v[5] = __uint_as_float(q.z & 0xFFFF0000u); v[6] = __uint_as_float(q.w << 16); v[7] = __uint_as_float(q.w & 0xFFFF0000u);
}
#define FOR_CHUNKS(st) _Pragma("unroll") for (int i_ = 0; i_ < 4; ++i_)
#define CHUNK_LOAD(st) const int cid_ = threadIdx.x + 256 * i_; const int sr_ = cid_ >> 4, col0_ = (cid_ & 15) * 8; float v_[8]; \
    { const float4 x0_ = *(const float4*)((st) + sr_ * 132 + col0_), x1_ = *(const float4*)((st) + sr_ * 132 + col0_ + 4); \
      v_[0] = x0_.x; v_[1] = x0_.y; v_[2] = x0_.z; v_[3] = x0_.w; v_[4] = x1_.x; v_[5] = x1_.y; v_[6] = x1_.z; v_[7] = x1_.w; }

DEV int cbar_() { asm volatile("" ::: "memory"); return 0; }
#define ZERO_ACC(acc) { _Pragma("unroll") for (int i_ = 0; i_ < 2; ++i_) _Pragma("unroll") for (int j_ = 0; j_ < 2; ++j_) _Pragma("unroll") for (int r_ = 0; r_ < 16; ++r_) acc[i_][j_][r_] = 0.f; }
#define FOR_ACC _Pragma("unroll") for (int mi = 0; mi < 2; ++mi) _Pragma("unroll") for (int ni = 0; ni < 2; ++ni) _Pragma("unroll") for (int r = cbar_(); r < 16; ++r)
#define ACC_ROW (wm_ * 64 + mi * 32 + (r & 3) + 8 * (r >> 2) + 4 * (lane_ >> 5))
#define ACC_COL (wn_ * 64 + ni * 32 + (lane_ & 31))
#define ACC_IDS const int lane_ = threadIdx.x & 63, wm_ = (threadIdx.x >> 6) >> 1, wn_ = (threadIdx.x >> 6) & 1;

struct WcJob { const float* src; const float* ksc; u16* dst; int ld, c0, c1, nvalid, K, k0; };
DEV WcJob wconv_decode(const Params& P, int job) {
    unsigned char* ws = P.ws;
    const float* src; const float* ksc = nullptr; u16* dst; int ld, c0, c1, nvalid = 64, K, kt, n0;
    if (job < 2080) {
        n0 = (job >> 4) * 64; kt = job & 15; K = 2048; src = P.w_in; ld = 8272;
        if (n0 < 4096) c0 = n0; else if (n0 < 8192) c0 = n0 + 80; else { c0 = n0 - 8192 + 4096; nvalid = min(64, max(0, 8272 - n0)); }
        c1 = c0 + 32;
        dst = (u16*)(ws + O_WIN) + (size_t)n0 * 2048;
    } else if (job < 2208) {
        const int lt = job - 2080; n0 = (lt >> 2) * 64; kt = lt & 3; K = 512; ld = 1024; ksc = P.g_q;
        if (n0 < 1024) { src = P.w_uq; c0 = n0; } else { src = P.w_uq_idx; c0 = n0 - 1024; }
        c1 = c0 + 32;
        dst = (u16*)(ws + O_WUQ) + (size_t)n0 * 512;
    } else if (job < 2464) {
        const int lt = job - 2208; n0 = (lt >> 3) * 64; kt = lt & 7; K = 1024; ld = 2048; src = P.w_glu;
        c0 = (n0 >> 6) * 32; c1 = 1024 + c0;
        dst = (u16*)(ws + O_WGLU) + (size_t)n0 * 1024;
    } else if (job < 2720) {
        const int lt = job - 2464; n0 = (lt >> 3) * 64; kt = lt & 7; K = 1024; ld = 2048; src = P.w_ssm_out; c0 = n0; c1 = c0 + 32;
        dst = (u16*)(ws + O_WSSMO) + (size_t)n0 * 1024;
    } else if (job < 2976) {
        const int lt = job - 2720; n0 = (lt >> 3) * 64; kt = lt & 7; K = 1024; ld = 2048; src = P.w_attn_out; c0 = n0; c1 = c0 + 32;
        dst = (u16*)(ws + O_WATTO) + (size_t)n0 * 1024;
    } else if (job < 3488) {
        const int lt = job - 2976; n0 = (lt >> 4) * 64; kt = lt & 15; K = 2048; ld = 2048; src = P.w_o; c0 = n0; c1 = c0 + 32;
        dst = (u16*)(ws + O_WO) + (size_t)n0 * 2048;
    } else if (job < 4000) {
        const int lt = job - 3488; n0 = (lt >> 4) * 64; kt = lt & 15; K = 2048; ld = 2048; src = P.w_ple_gate; c0 = n0; c1 = c0 + 32; ksc = P.g_ple;
        dst = (u16*)(ws + O_WPG) + (size_t)n0 * 2048;
    } else {
        const int lt = job - 4000; n0 = (lt >> 1) * 64; kt = lt & 1; K = 256; ld = 2048; src = P.w_ple; c0 = n0; c1 = c0 + 32;
        dst = (u16*)(ws + O_WPLE) + (size_t)n0 * 256;
    }
    WcJob j; j.src = src; j.ksc = ksc; j.dst = dst; j.ld = ld; j.c0 = c0; j.c1 = c1; j.nvalid = nvalid; j.K = K; j.k0 = kt * 128;
    return j;
}
DEV void wconv_load(const WcJob& j, float4 (&v)[8]) {
    const int tid = threadIdx.x;
    const int c = (tid & 15) * 4;
    const int sc = (c < 32) ? (j.c0 + c) : (j.c1 + c - 32);
#pragma unroll
    for (int it = 0; it < 8; ++it) {
        const int kr = it * 16 + (tid >> 4);
        v[it] = make_float4(0.f, 0.f, 0.f, 0.f);
        if (c < j.nvalid) v[it] = *(const float4*)(j.src + (size_t)(j.k0 + kr) * j.ld + sc);
    }
}
DEV void wconv_finish(const WcJob& j, const float4 (&v)[8], u16* tile) {
    const int tid = threadIdx.x;
    const int c = (tid & 15) * 4;
#pragma unroll
    for (int it = 0; it < 8; ++it) {
        const int kr = it * 16 + (tid >> 4);
        const float f = j.ksc ? j.ksc[j.k0 + kr] : 1.f;
        uint2 o; o.x = pack2(v[it].x * f, v[it].y * f); o.y = pack2(v[it].z * f, v[it].w * f);
        *(uint2*)(tile + kr * 68 + c) = o;
    }
    __syncthreads();
    const int n = tid & 63, kq = (tid >> 6) * 32;
    u16* dp = j.dst + (size_t)n * j.K + j.k0 + kq;
#pragma unroll
    for (int h = 0; h < 4; ++h) {
        uint32_t w[4];
#pragma unroll
        for (int e = 0; e < 4; ++e) w[e] = (uint32_t)tile[(kq + h * 8 + 2 * e) * 68 + n] | ((uint32_t)tile[(kq + h * 8 + 2 * e + 1) * 68 + n] << 16);
        *(uint4*)(dp + h * 8) = make_uint4(w[0], w[1], w[2], w[3]);
    }
    __syncthreads();
}
DEV void wconv_run(const Params& P, int first, int end, int stride, u16* tile) {
    if (first >= end) return;
    float4 va[8], vb[8];
    wconv_load(wconv_decode(P, first), va);
    for (int job = first; job < end; job += 2 * stride) {
        if (job + stride < end) wconv_load(wconv_decode(P, job + stride), vb);
        wconv_finish(wconv_decode(P, job), va, tile);
        if (job + stride < end) {
            if (job + 2 * stride < end) wconv_load(wconv_decode(P, job + 2 * stride), va);
            wconv_finish(wconv_decode(P, job + stride), vb, tile);
        }
    }
}

DEV void phaseA(const Params& P, unsigned char* smem) {
    const int tid = threadIdx.x, lane = tid & 63, wid = tid >> 6;
    const int nb = gridDim.x;
    unsigned char* ws = P.ws;
    wconv_run(P, blockIdx.x, 2208, nb, (u16*)smem);
    for (int job = blockIdx.x; job < 2048; job += nb) {
        const int row = job * 4 + wid;
        const float4* xr = (const float4*)(P.x + (size_t)row * 2048);
        const float4* gr = (const float4*)P.g_mix;
        float4 v[8];
        float ss = 0.f;
#pragma unroll
        for (int i = 0; i < 8; ++i) { v[i] = xr[lane + 64 * i]; ss += v[i].x * v[i].x + v[i].y * v[i].y + v[i].z * v[i].z + v[i].w * v[i].w; }
        ss = wave_sum(ss);
        const float rinv = rsqrtf(ss * (1.f / 2048.f) + 1e-6f);
        u16* hr = (u16*)(ws + O_H) + (size_t)row * 2048;
#pragma unroll
        for (int i = 0; i < 8; ++i) {
            const float4 g = gr[lane + 64 * i];
            uint2 o; o.x = pack2(v[i].x * rinv * g.x, v[i].y * rinv * g.y); o.y = pack2(v[i].z * rinv * g.z, v[i].w * rinv * g.w);
            *(uint2*)(hr + (lane + 64 * i) * 4) = o;
        }
    }
    for (int job = blockIdx.x; job < 16; job += nb) {
        const int gn = job * 256 + tid, g = gn >> 6, n = gn & 63;
        const float dt = expf(P.log_dt[g]);
        const float ar = P.a_re[gn], ai = P.a_im[gn];
        const float mag = expf(dt * ar);
        const float abr = mag * cosf(dt * ai), abi = mag * sinf(dt * ai);
        const float den = ar * ar + ai * ai, nr = abr - 1.f;
        const float fr = (nr * ar + abi * ai) / den, fi = (abi * ar - nr * ai) / den;
        ((float2*)(ws + O_ABAR))[gn] = make_float2(abr, abi);
        float pr = abr, pi = abi;
#pragma unroll
        for (int s = 0; s < 8; ++s) { const float t = pr * pr - pi * pi; pi = 2.f * pr * pi; pr = t; }
        ((float2*)(ws + O_ABART))[gn] = make_float2(pr, pi);
        const int rc = (n >> 5) * 64 + (n & 31), ic = rc + 32;
        u16* bbt = (u16*)(ws + O_BBT) + (size_t)g * 128 * 16;
        u16* cct = (u16*)(ws + O_CCT) + (size_t)g * 32 * 128;
        for (int c = 0; c < 16; ++c) {
            const float br = P.b_re[gn * 16 + c], bi = P.b_im[gn * 16 + c];
            bbt[rc * 16 + c] = f2bf(fr * br - fi * bi);
            bbt[ic * 16 + c] = f2bf(fr * bi + fi * br);
            cct[c * 128 + rc] = f2bf(P.c_re[(g * 16 + c) * 64 + n]);
            cct[c * 128 + ic] = f2bf(-P.c_im[(g * 16 + c) * 64 + n]);
            cct[(16 + c) * 128 + rc] = 0;
            cct[(16 + c) * 128 + ic] = 0;
        }
    }
}

DEV void phaseB(const Params& P, unsigned char* smem) {
    ACC_IDS
    unsigned char* ws = P.ws;
    for (int job = blockIdx.x; job < 4160 + 1856 + 1024; job += gridDim.x) {
        if (job >= 4160) {
            if (job < 4160 + 1856) { const WcJob wj = wconv_decode(P, job - 4160 + 2208); float4 vv[8]; wconv_load(wj, vv); wconv_finish(wj, vv, (u16*)smem); }
            else {
                const size_t e0 = (size_t)(job - 4160 - 1856) * 2048 + threadIdx.x * 8;
                const float4 a = *(const float4*)(P.p + e0), b = *(const float4*)(P.p + e0 + 4);
                uint4 o; o.x = pack2(a.x, a.y); o.y = pack2(a.z, a.w); o.z = pack2(b.x, b.y); o.w = pack2(b.z, b.w);
                *(uint4*)((u16*)(ws + O_PBF) + e0) = o;
            }
            continue;
        }
        const int mt = job & 63, nt = job >> 6;
        f32x16 acc[2][2];
        ZERO_ACC(acc);
        gemm_mainloop((const u16*)(ws + O_H) + (size_t)mt * 128 * 2048, 2048, (const u16*)(ws + O_WIN) + (size_t)nt * 128 * 2048, 2048, 2048, smem, acc);
        const int m0 = mt * 128;
        float* st = (float*)smem;
        u16* dst = nullptr; int ld = 0, cofs = 0, act = 0;
        if (nt < 8) { dst = (u16*)(ws + O_U); ld = 1024; cofs = nt * 128; }
        else if (nt < 16) { dst = (u16*)(ws + O_ZS); ld = 1024; cofs = (nt - 8) * 128; act = 1; }
        else if (nt < 20) { dst = (u16*)(ws + O_CQ); ld = 512; cofs = (nt - 16) * 128; }
        else if (nt < 22) { dst = (u16*)(ws + O_K); ld = 256; cofs = (nt - 20) * 128; }
        else if (nt < 24) { dst = (u16*)(ws + O_V); ld = 256; cofs = (nt - 22) * 128; }
        else if (nt < 32) { dst = (u16*)(ws + O_ZA); ld = 1024; cofs = (nt - 24) * 128; act = 1; }
        else if (nt < 48) { dst = (u16*)(ws + O_GS); ld = 2048; cofs = (nt - 32) * 128; act = 2; }
        else if (nt < 64) { dst = (u16*)(ws + O_GA); ld = 2048; cofs = (nt - 48) * 128; act = 2; }
#pragma unroll 1
        for (int mi = 0; mi < 2; ++mi) {
            stage_half(acc, mi, st);
            FOR_CHUNKS(st) {
                CHUNK_LOAD(st)
                const int row = m0 + SR_TO_ROW(sr_, mi);
                if (nt < 64) {
                    if (act == 1) { _Pragma("unroll") for (int e = 0; e < 8; ++e) v_[e] = siluf_(v_[e]); }
                    else if (act == 2) { _Pragma("unroll") for (int e = 0; e < 8; ++e) v_[e] = sigmoidf_(v_[e]); }
                    st_nt16(dst + (size_t)row * ld + cofs + col0_, pack8(v_));
                    if (nt >= 16 && nt < 20) {
                        float ss = 0.f;
                        _Pragma("unroll") for (int e = 0; e < 8; ++e) ss += v_[e] * v_[e];
                        ss += __shfl_xor(ss, 1); ss += __shfl_xor(ss, 2); ss += __shfl_xor(ss, 4); ss += __shfl_xor(ss, 8);
                        if ((threadIdx.x & 15) == 0) ((float*)(ws + O_SSQC))[(size_t)row * 4 + (nt - 16)] = ss;
                    }
                } else if (col0_ < 64) {
                    float* kr = (float*)(ws + O_KIDXRAW) + (size_t)row * 64 + col0_;
                    *(float4*)kr = make_float4(v_[0], v_[1], v_[2], v_[3]);
                    *(float4*)(kr + 4) = make_float4(v_[4], v_[5], v_[6], v_[7]);
                } else if (col0_ < 80) {
                    float* wr = (float*)(ws + O_WIDX) + (size_t)row * 16 + (col0_ - 64);
                    const float sc = 1.f / 32.f;
                    *(float4*)wr = make_float4(v_[0] * sc, v_[1] * sc, v_[2] * sc, v_[3] * sc);
                    *(float4*)(wr + 4) = make_float4(v_[4] * sc, v_[5] * sc, v_[6] * sc, v_[7] * sc);
                }
            }
            __syncthreads();
        }
    }
}

template <bool PASS2>
DEV void s5_unit(const Params& P, int g, int c, unsigned char* wsm) {
    const int lane = threadIdx.x & 63;
    const int l31 = lane & 31, hl = lane >> 5;
    unsigned char* ws = P.ws;
    float* bu = (float*)wsm;
    const u16* U = (const u16*)(ws + O_U);
    const u16* bbt = (const u16*)(ws + O_BBT) + (size_t)g * 128 * 16;
    bf16x8 bb0 = *(const bf16x8*)(bbt + (0 * 32 + l31) * 16 + 8 * hl);
    bf16x8 bb1 = *(const bf16x8*)(bbt + (1 * 32 + l31) * 16 + 8 * hl);
    bf16x8 bb2 = *(const bf16x8*)(bbt + (2 * 32 + l31) * 16 + 8 * hl);
    bf16x8 bb3 = *(const bf16x8*)(bbt + (3 * 32 + l31) * 16 + 8 * hl);
    const float2 ab = ((const float2*)(ws + O_ABAR))[g * 64 + lane];
    const int rc = (lane >> 5) * 64 + l31, ic = rc + 32;
    bf16x8 cfr[8];
    bf16x8 dfr = {0, 0, 0, 0, 0, 0, 0, 0};
    if (PASS2) {
        const short dbf = (short)f2bf(P.d_skip[g * 16 + (l31 & 15)]);
#pragma unroll
        for (int j = 0; j < 8; ++j) dfr[j] = (l31 == 8 * hl + j) ? dbf : (short)0;
    }
    if (PASS2) {
        const u16* cct = (const u16*)(ws + O_CCT) + (size_t)g * 32 * 128;
#pragma unroll
        for (int ks = 0; ks < 8; ++ks) cfr[ks] = *(const bf16x8*)(cct + l31 * 128 + ks * 16 + 8 * hl);
    }
    float hr = 0.f, hi = 0.f;
    if (PASS2) {
        const float2 abT = ((const float2*)(ws + O_ABART))[g * 64 + lane];
        const float2* E = (const float2*)(ws + O_ENDST);
        for (int cc = 0; cc < c; ++cc) {
            const float2 e = E[((size_t)cc * 64 + g) * 64 + lane];
            const float t = abT.x * hr - abT.y * hi + e.x;
            hi = abT.x * hi + abT.y * hr + e.y;
            hr = t;
        }
    }
    bf16x8 ua_next = __builtin_nontemporal_load((const bf16x8*)(U + (size_t)(c * 256 + l31) * 1024 + g * 16 + 8 * hl));
    for (int st = 0; st < 8; ++st) {
        const int t0 = c * 256 + st * 32;
        const bf16x8 ua = ua_next;
        if (st + 1 < 8) ua_next = __builtin_nontemporal_load((const bf16x8*)(U + (size_t)(t0 + 32 + l31) * 1024 + g * 16 + 8 * hl));
        f32x16 z;
#pragma unroll
        for (int r = 0; r < 16; ++r) z[r] = 0.f;
        f32x16 c0 = __builtin_amdgcn_mfma_f32_32x32x16_bf16(ua, bb0, z, 0, 0, 0);
        f32x16 c1 = __builtin_amdgcn_mfma_f32_32x32x16_bf16(ua, bb1, z, 0, 0, 0);
        f32x16 c2 = __builtin_amdgcn_mfma_f32_32x32x16_bf16(ua, bb2, z, 0, 0, 0);
        f32x16 c3 = __builtin_amdgcn_mfma_f32_32x32x16_bf16(ua, bb3, z, 0, 0, 0);
        LDS_FENCE();
#pragma unroll
        for (int r = 0; r < 16; ++r) {
            const int row = (r & 3) + 8 * (r >> 2) + 4 * hl;
            bu[row * 132 + l31] = c0[r];
            bu[row * 132 + 32 + l31] = c1[r];
            bu[row * 132 + 64 + l31] = c2[r];
            bu[row * 132 + 96 + l31] = c3[r];
        }
        LDS_FENCE();
#pragma unroll
        for (int hb = 0; hb < 2; ++hb) {
            float vr[16], vi[16];
#pragma unroll
            for (int r = 0; r < 16; ++r) { vr[r] = bu[(hb * 16 + r) * 132 + rc]; vi[r] = bu[(hb * 16 + r) * 132 + ic]; }
            LDS_FENCE();
#pragma unroll
            for (int r = 0; r < 16; ++r) {
                const float t = ab.x * hr - ab.y * hi + vr[r];
                hi = ab.x * hi + ab.y * hr + vi[r];
                hr = t;
                if (PASS2) {
                    u16* hrow = (u16*)(bu + (hb * 16 + r) * 132);
                    hrow[rc] = f2bf(hr);
                    hrow[ic] = f2bf(hi);
                }
            }
        }
        if (PASS2) {
            LDS_FENCE();
            f32x16 y;
#pragma unroll
            for (int r = 0; r < 16; ++r) y[r] = 0.f;
#pragma unroll
            for (int ks = 0; ks < 8; ++ks) {
                const bf16x8 ha = *(const bf16x8*)((const unsigned char*)bu + l31 * 528 + (ks * 16 + 8 * hl) * 2);
                y = __builtin_amdgcn_mfma_f32_32x32x16_bf16(ha, cfr[ks], y, 0, 0, 0);
            }
            y = __builtin_amdgcn_mfma_f32_32x32x16_bf16(ua, dfr, y, 0, 0, 0);
            if (l31 < 16) {
#pragma unroll
                for (int r = 0; r < 16; ++r) {
                    const int tl = (r & 3) + 8 * (r >> 2) + 4 * hl;
                    ((u16*)((unsigned char*)bu + tl * 528 + 256))[l31] = f2bf(geluf_(y[r]));
                }
            }
            LDS_FENCE();
            if (lane < 32) {
                const uint4 y0 = *(const uint4*)((const unsigned char*)bu + lane * 528 + 256), y1 = *(const uint4*)((const unsigned char*)bu + lane * 528 + 272);
                u16* yp = (u16*)(ws + O_YACT) + (size_t)(t0 + lane) * 1024 + g * 16;
                typedef unsigned u32x4n __attribute__((ext_vector_type(4))); const u32x4n n0_ = {y0.x, y0.y, y0.z, y0.w}, n1_ = {y1.x, y1.y, y1.z, y1.w};
                __builtin_nontemporal_store(n0_, (u32x4n*)yp); __builtin_nontemporal_store(n1_, (u32x4n*)(yp + 8));
            }
            LDS_FENCE();
        }
    }
    if (!PASS2) ((float2*)(ws + O_ENDST))[((size_t)c * 64 + g) * 64 + lane] = make_float2(hr, hi);
}

DEV void phaseC(const Params& P, unsigned char* smem) {
    ACC_IDS
    const int tid = threadIdx.x, wid = tid >> 6;
    unsigned char* ws = P.ws;
    float* rinv_s = (float*)(smem + 65536);
    for (int job = blockIdx.x; job < 1024 + 32 + 512; job += gridDim.x) {
        if (job < 1024) {
            const int mt = job & 63, nt = job >> 6, m0 = mt * 128;
            const u16* cq = (const u16*)(ws + O_CQ);
            if (tid < 128) {
                const float4 q = *(const float4*)((const float*)(ws + O_SSQC) + (size_t)(m0 + tid) * 4);
                rinv_s[tid] = rsqrtf((q.x + q.y + q.z + q.w) * (1.f / 512.f) + 1e-6f);
            }
            f32x16 acc[2][2];
            ZERO_ACC(acc);
            gemm_mainloop(cq + (size_t)m0 * 512, 512, (const u16*)(ws + O_WUQ) + (size_t)nt * 128 * 512, 512, 512, smem, acc);
            u16* dst = (u16*)(ws + (nt < 8 ? O_Q : O_QIDX));
            const int cofs = (nt & 7) * 128;
            float* st = (float*)smem;
#pragma unroll 1
            for (int mi = 0; mi < 2; ++mi) {
                stage_half(acc, mi, st);
                FOR_CHUNKS(st) {
                    CHUNK_LOAD(st)
                    const int rl = SR_TO_ROW(sr_, mi);
                    const float ri = rinv_s[rl];
                    _Pragma("unroll") for (int e = 0; e < 8; ++e) v_[e] *= ri;
                    *(uint4*)(dst + (size_t)(m0 + rl) * 1024 + cofs + col0_) = pack8(v_);
                }
                __syncthreads();
            }
        } else if (job < 1056) {
            const int row = (job - 1024) * 256 + tid;
            const float4* kr = (const float4*)((const float*)(ws + O_KIDXRAW) + (size_t)row * 64);
            float4 v[16];
            float ss = 0.f;
#pragma unroll
            for (int i = 0; i < 16; ++i) { v[i] = kr[i]; ss += v[i].x * v[i].x + v[i].y * v[i].y + v[i].z * v[i].z + v[i].w * v[i].w; }
            const float rinv = rsqrtf(ss * (1.f / 64.f) + 1e-6f);
            const float4* gk = (const float4*)P.g_kidx;
            u16* o = (u16*)(ws + O_KIDX) + (size_t)(row >> 5) * 2048 + (row & 31) * 8;
#pragma unroll
            for (int i = 0; i < 16; ++i) {
                const float4 g = gk[i];
                uint2 w; w.x = pack2(v[i].x * rinv * g.x, v[i].y * rinv * g.y); w.y = pack2(v[i].z * rinv * g.z, v[i].w * rinv * g.w);
                *(uint2*)(o + (i >> 1) * 256 + (i & 1) * 4) = w;
            }
        } else {
            const int unit = (job - 1056) * 4 + wid;
            s5_unit<false>(P, unit & 63, unit >> 6, smem + wid * 16896);
        }
    }
}

constexpr int RW = 8208;
constexpr uint32_t PADKEY = 0x0EB60D35u;
DEV int bucket_of(float sc) { return (int)fminf(fmaxf((sc + 4.f) * 32.f, 0.f), 255.f); }
DEV float key2f(uint32_t k) { return __uint_as_float((k & 0x80000000u) ? (k ^ 0x80000000u) : ~k); }
DEV int bucket_of_key(uint32_t k) { return (k == PADKEY) ? -1 : bucket_of(key2f(k)); }
DEV uint32_t first_key_with_bucket(int bt) {
    const int lane = threadIdx.x & 63;
    uint32_t lo = PADKEY, hi = 0xFF800000u;
    while (hi - lo > 1u) {
        const uint32_t span = hi - lo, step = (span + 63u) >> 6;
        const unsigned long long off = (unsigned long long)step * (unsigned)(lane + 1);
        const uint32_t cand = (off >= span) ? hi : lo + (uint32_t)off;
        const bool pr = bucket_of_key(cand) >= bt;
        const int f = __ffsll((long long)__ballot(pr)) - 1;
        const uint32_t nhi = (uint32_t)__shfl((int)cand, f);
        const unsigned long long offl = (unsigned long long)step * (unsigned)f;
        const uint32_t nlo = (f == 0) ? lo : ((offl >= span) ? hi : lo + (uint32_t)offl);
        hi = nhi; lo = nlo;
    }
    return hi;
}
DEV uint32_t f2key(float f) { const uint32_t u = __float_as_uint(f); return u ^ ((uint32_t)((int32_t)u >> 31) | 0x80000000u); }

DEV void idx_score_tile(const bf16x8 (&a)[4], const bf16x8 (&b)[4], const float (&w)[16], float& p0, float& p1) {
    f32x16 acc;
#pragma unroll
    for (int r = 0; r < 16; ++r) acc[r] = 0.f;
#pragma unroll
    for (int ks = 0; ks < 4; ++ks) acc = __builtin_amdgcn_mfma_f32_32x32x16_bf16(a[ks], b[ks], acc, 0, 0, 0);
    p0 = 0.f; p1 = 0.f;
#pragma unroll
    for (int r = 0; r < 8; ++r) { p0 += w[r] * fmaxf(acc[r], 0.f); p1 += w[r + 8] * fmaxf(acc[r + 8], 0.f); }
    typedef unsigned u32x2_ __attribute__((ext_vector_type(2)));
    const u32x2_ sw = __builtin_amdgcn_permlane32_swap(__float_as_uint(p0), __float_as_uint(p1), false, false);
    p0 = __uint_as_float(sw[0]) + __uint_as_float(sw[1]);
    p1 = p0;
}

DEV void attn_job(const Params& P, int j, int rot, unsigned char* smem) {
    const int tid = threadIdx.x, lane = tid & 63, wid = tid >> 6;
    const int l31 = lane & 31, hl = lane >> 5;
    unsigned char* ws = P.ws;
    uint32_t* rows = (uint32_t*)smem;
    uint32_t* hist_all = (uint32_t*)(smem + 2 * RW * 4);
    const int tl0 = 2 * j, tl1 = 2 * j + 1, th0 = 8190 - 2 * j, th1 = 8191 - 2 * j;
    uint32_t* rowL0 = rows;
    uint32_t* rowH1 = rows + ((tl0 + 4) & ~3);
    uint32_t* rowL1 = rows + RW;
    uint32_t* rowH0 = rows + RW + ((tl1 + 4) & ~3);
    const int role = wid ^ ((rot & 1) << 1);
    hist_all[tid] = 0u; hist_all[tid + 256] = 0u; hist_all[tid + 512] = 0u; hist_all[tid + 768] = 0u;
    __syncthreads();
    const u16* QI = (const u16*)(ws + O_QIDX);
    const u16* KI = (const u16*)(ws + O_KIDX);
    const float* WI = (const float*)(ws + O_WIDX);
    for (int rep1 = 0; rep1 < (PROBE_SEC == 1 ? 2 : 1); ++rep1) {
        bf16x8 aL[4], aH[4];
        float wL[16], wH[16];
        {
            const int qi = l31 >> 4, head = l31 & 15;
            const u16* pl = QI + (size_t)(qi ? tl1 : tl0) * 1024 + head * 64 + 8 * hl;
            const u16* ph = QI + (size_t)(qi ? th1 : th0) * 1024 + head * 64 + 8 * hl;
#pragma unroll
            for (int ks = 0; ks < 4; ++ks) { aL[ks] = __builtin_nontemporal_load((const bf16x8*)(pl + ks * 16)); aH[ks] = __builtin_nontemporal_load((const bf16x8*)(ph + ks * 16)); }
#pragma unroll
            for (int r = 0; r < 16; ++r) {
                const int q = r >> 3, hd = (r & 3) + 8 * ((r >> 2) & 1) + 4 * hl;
                wL[r] = WI[(size_t)(q ? tl1 : tl0) * 16 + hd];
                wH[r] = WI[(size_t)(q ? th1 : th0) * 16 + hd];
            }
        }
        const int nkt = (th1 >> 5) + 1;
        bf16x8 bq[3][4];
#define KLOAD(u, ktv) { const int kc_ = min((ktv), nkt - 1); const u16* kp_ = KI + (size_t)kc_ * 2048 + hl * 256 + l31 * 8; \
            _Pragma("unroll") for (int ks = 0; ks < 4; ++ks) bq[u][ks] = *(const bf16x8*)(kp_ + ks * 512); }
        uint32_t* const rowHs = hl ? rowH1 : rowH0; const int tHs = hl ? th1 : th0; uint32_t* const hHs = hist_all + (2 + hl) * 256;
        uint32_t* const rowLs = hl ? rowL1 : rowL0; const int tLs = hl ? tl1 : tl0; uint32_t* const hLs = hist_all + hl * 256;
#define ROWPUT(rowp, hp, tq, pv) if (key < (((tq) + 4) & ~3)) { const bool ok_ = key <= (tq); rowp[key] = ok_ ? f2key(pv) : PADKEY; if (ok_) atomicAdd(&hp[bucket_of(pv)], 1u); }
#define KTILE(u, ktv) if ((ktv) < nkt) { const int key = (ktv) * 32 + l31; float p0, p1; \
            idx_score_tile(aH, bq[u], wH, p0, p1); \
            ROWPUT(rowHs, hHs, tHs, p0) \
            if ((ktv) * 32 <= tl1) { idx_score_tile(aL, bq[u], wL, p0, p1); ROWPUT(rowLs, hLs, tLs, p0) } }
        KLOAD(0, wid) KLOAD(1, wid + 4) KLOAD(2, wid + 8)
        for (int kt = wid; kt < nkt; kt += 12) {
            KTILE(0, kt) KLOAD(0, kt + 12)
            KTILE(1, kt + 4) KLOAD(1, kt + 16)
            KTILE(2, kt + 8) KLOAD(2, kt + 20)
        }
#undef KLOAD
#undef KTILE
#undef ROWPUT
    }
    __syncthreads();
    uint32_t* row; int t;
    if (role == 0) { row = rowL0; t = tl0; } else if (role == 1) { row = rowL1; t = tl1; } else if (role == 2) { row = rowH0; t = th0; } else { row = rowH1; t = th1; }
    const int n = t + 1;
    uint32_t* hrow = hist_all + role * 256;
    u16* idxl = (u16*)hrow;
    u16* cand = idxl + 256;
    int nsel;
    for (int rep2 = 0; rep2 < (PROBE_SEC == 2 ? 2 : 1); ++rep2)
    if (n <= 256) {
        nsel = n;
        LDS_FENCE();
        for (int i = lane; i < 256; i += 64) idxl[i] = (u16)((i < n) ? i : 0);
    } else {
        nsel = 256;
        int b0; uint32_t kkb, cntb;
        {
            const uint32_t c0 = hrow[255 - 4 * lane], c1 = hrow[254 - 4 * lane], c2 = hrow[253 - 4 * lane], c3 = hrow[252 - 4 * lane];
            const uint32_t sm = c0 + c1 + c2 + c3;
            uint32_t incl = sm;
#pragma unroll
            for (int d = 1; d < 64; d <<= 1) { const uint32_t v = __shfl_up(incl, d); if (lane >= d) incl += v; }
            uint32_t e = incl - sm;
            const bool hit = (e < 256u) && (256u <= incl);
            const int srcl = __ffsll((long long)__ballot(hit)) - 1;
            int bin; uint32_t nk, cb;
            if (e + c0 >= 256u) { bin = 255 - 4 * lane; nk = 256u - e; cb = c0; }
            else { e += c0; if (e + c1 >= 256u) { bin = 254 - 4 * lane; nk = 256u - e; cb = c1; }
            else { e += c1; if (e + c2 >= 256u) { bin = 253 - 4 * lane; nk = 256u - e; cb = c2; }
            else { e += c2; bin = 252 - 4 * lane; nk = 256u - e; cb = c3; } } }
            b0 = __shfl(bin, srcl); kkb = __shfl(nk, srcl); cntb = __shfl(cb, srcl);
        }
        LDS_FENCE();
        if (cntb <= 256u) {
            const int n4 = (n + 3) & ~3;
            const int ngt = 256 - (int)kkb;
            const uint32_t khi = (b0 >= 255) ? 0xFFFFFFFFu : first_key_with_bucket(b0 + 1);
            const uint32_t klo = (b0 <= 0) ? (PADKEY + 1u) : first_key_with_bucket(b0);
            uint32_t cg = 0, ce = 0;
            for (int i4 = lane * 4; i4 < n4; i4 += 256) {
                const uint4 k4 = *(const uint4*)(row + i4);
                cg += (k4.x >= khi) + (k4.y >= khi) + (k4.z >= khi) + (k4.w >= khi);
                ce += (k4.x >= klo) + (k4.y >= klo) + (k4.z >= klo) + (k4.w >= klo);
            }
            ce -= cg;
            uint32_t ig = cg, ie = ce;
#pragma unroll
            for (int d = 1; d < 64; d <<= 1) {
                const uint32_t vg = __shfl_up(ig, d), ve = __shfl_up(ie, d);
                if (lane >= d) { ig += vg; ie += ve; }
            }
            uint32_t bg = ig - cg, be = ie - ce;
            for (int i4 = lane * 4; i4 < n4; i4 += 256) {
                const uint4 k4 = *(const uint4*)(row + i4);
                const uint32_t kv[4] = {k4.x, k4.y, k4.z, k4.w};
#pragma unroll
                for (int e = 0; e < 4; ++e) {
                    if (kv[e] >= khi) { idxl[bg] = (u16)(i4 + e); ++bg; }
                    else if (kv[e] >= klo) { cand[be] = (u16)(i4 + e); ++be; }
                }
            }
            LDS_FENCE();
            uint32_t ck[4]; int ci[4];
#pragma unroll
            for (int c = 0; c < 4; ++c) { const int q = lane + 64 * c; ci[c] = (q < (int)cntb) ? (int)cand[q] : 0; }
#pragma unroll
            for (int c = 0; c < 4; ++c) ck[c] = row[ci[c]];
            LDS_FENCE();
#pragma unroll
            for (int c = 0; c < 4; ++c) { const int q = lane + 64 * c; if (q < (int)cntb) row[q] = ck[c]; }
            LDS_FENCE();
            uint32_t rk[4] = {0u, 0u, 0u, 0u};
            for (int jq = 0; jq < (int)cntb; ++jq) {
                const uint32_t kj = row[jq];
#pragma unroll
                for (int c = 0; c < 4; ++c) rk[c] += ((kj > ck[c]) || (kj == ck[c] && jq < lane + 64 * c)) ? 1u : 0u;
            }
#pragma unroll
            for (int c = 0; c < 4; ++c) { const int q = lane + 64 * c; if (q < (int)cntb && rk[c] < kkb) idxl[ngt + rk[c]] = (u16)ci[c]; }
        } else {
        uint32_t prefix = 0, kk = 256;
        for (int pass = 0; pass < 4; ++pass) {
            const int shift = 24 - 8 * pass;
            hrow[lane] = 0; hrow[lane + 64] = 0; hrow[lane + 128] = 0; hrow[lane + 192] = 0;
            LDS_FENCE();
            const int n4 = (n + 3) & ~3;
            if (pass == 0) {
                for (int i4 = lane * 4; i4 < n4; i4 += 256) {
                    const uint4 k4 = *(const uint4*)(row + i4);
                    atomicAdd(&hrow[k4.x >> 24], 1u); atomicAdd(&hrow[k4.y >> 24], 1u); atomicAdd(&hrow[k4.z >> 24], 1u); atomicAdd(&hrow[k4.w >> 24], 1u);
                }
            } else {
                const int sh8 = shift + 8;
                for (int i4 = lane * 4; i4 < n4; i4 += 256) {
                    const uint4 k4 = *(const uint4*)(row + i4);
                    if ((k4.x >> sh8) == prefix) atomicAdd(&hrow[(k4.x >> shift) & 255u], 1u);
                    if ((k4.y >> sh8) == prefix) atomicAdd(&hrow[(k4.y >> shift) & 255u], 1u);
                    if ((k4.z >> sh8) == prefix) atomicAdd(&hrow[(k4.z >> shift) & 255u], 1u);
                    if ((k4.w >> sh8) == prefix) atomicAdd(&hrow[(k4.w >> shift) & 255u], 1u);
                }
            }
            LDS_FENCE();
            const uint32_t c0 = hrow[255 - 4 * lane], c1 = hrow[254 - 4 * lane], c2 = hrow[253 - 4 * lane], c3 = hrow[252 - 4 * lane];
            const uint32_t s = c0 + c1 + c2 + c3;
            uint32_t incl = s;
#pragma unroll
            for (int d = 1; d < 64; d <<= 1) { const uint32_t v = __shfl_up(incl, d); if (lane >= d) incl += v; }
            uint32_t e = incl - s;
            const bool hit = (e < kk) && (kk <= incl);
            const unsigned long long bm = __ballot(hit);
            const int srcl = __ffsll((long long)bm) - 1;
            int bin; uint32_t nk;
            if (e + c0 >= kk) { bin = 255 - 4 * lane; nk = kk - e; }
            else { e += c0; if (e + c1 >= kk) { bin = 254 - 4 * lane; nk = kk - e; }
            else { e += c1; if (e + c2 >= kk) { bin = 253 - 4 * lane; nk = kk - e; }
            else { e += c2; bin = 252 - 4 * lane; nk = kk - e; } } }
            bin = __shfl(bin, srcl);
            nk = __shfl(nk, srcl);
            prefix = (prefix << 8) | (uint32_t)bin;
            kk = nk;
            LDS_FENCE();
        }
        const uint32_t T = prefix;
        const int ngt = 256 - (int)kk;
        const int n4 = (n + 3) & ~3;
        uint32_t cg = 0, ce = 0;
        for (int i4 = lane * 4; i4 < n4; i4 += 256) {
            const uint4 k4 = *(const uint4*)(row + i4);
            cg += (k4.x > T) + (k4.y > T) + (k4.z > T) + (k4.w > T);
            ce += (k4.x == T) + (k4.y == T) + (k4.z == T) + (k4.w == T);
        }
        uint32_t ig = cg, ie = ce;
#pragma unroll
        for (int d = 1; d < 64; d <<= 1) {
            const uint32_t vg = __shfl_up(ig, d), ve = __shfl_up(ie, d);
            if (lane >= d) { ig += vg; ie += ve; }
        }
        uint32_t bg = ig - cg, be = ie - ce;
        for (int i4 = lane * 4; i4 < n4; i4 += 256) {
            const uint4 k4 = *(const uint4*)(row + i4);
            const uint32_t kv[4] = {k4.x, k4.y, k4.z, k4.w};
#pragma unroll
            for (int e = 0; e < 4; ++e) {
                if (kv[e] > T) { idxl[bg] = (u16)(i4 + e); ++bg; }
                else if (kv[e] == T) { if (be < kk) idxl[ngt + be] = (u16)(i4 + e); ++be; }
            }
        }
        }
    }
    __syncthreads();
    float* lg = (float*)(smem + ((role == 0 || role == 3) ? 0 : RW * 4) + ((role >= 2) ? (RW * 2) : 0));
    const u16* Qp = (const u16*)(ws + O_Q) + (size_t)t * 1024;
    const u16* Kb = (const u16*)(ws + O_K);
    const u16* Vb = (const u16*)(ws + O_V);
    const int l15 = lane & 15, q4 = lane >> 4;
    const float scale = 0.08838834764831845f;
    unsigned char* scr = (unsigned char*)lg;
    for (int rep3 = 0; rep3 < (PROBE_SEC == 3 ? 2 : 1); ++rep3) {
    {
        unsigned char* ktile = scr + 8192;
        unsigned kwofs[8], krd[2][4];
#pragma unroll
        for (int i = 0; i < 8; ++i) { const unsigned row = q4 + 4 * i, ch = l15; kwofs[i] = 256u * row + 16u * (ch ^ (((row & 3) << 2) | ((row >> 2) & 3))); }
#pragma unroll
        for (int rb = 0; rb < 2; ++rb)
#pragma unroll
            for (int sx = 0; sx < 4; ++sx) { const unsigned row = l15 + 16 * rb, ch = 4 * sx + q4; krd[rb][sx] = 256u * row + 16u * (ch ^ (((row & 3) << 2) | ((row >> 2) & 3))); }
        uint4 kr0, kr1, kr2, kr3, kr4, kr5, kr6, kr7;
#define KLD1(i, dst) { const int key = idxl[ck_ * 32 + q4 + 4 * (i)]; dst = *(const uint4*)(Kb + (size_t)key * 256 + g_ * 128 + l15 * 8); }
#define KGLOAD(it_) { const int g_ = (it_) >> 3, ck_ = (it_) & 7; KLD1(0, kr0) KLD1(1, kr1) KLD1(2, kr2) KLD1(3, kr3) KLD1(4, kr4) KLD1(5, kr5) KLD1(6, kr6) KLD1(7, kr7) }
        KGLOAD(0)
#pragma unroll 1
        for (int g = 0; g < 2; ++g) {
            bf16x8 qa[4];
#pragma unroll
            for (int ks = 0; ks < 4; ++ks) {
                bf16x8 z = {0, 0, 0, 0, 0, 0, 0, 0};
                qa[ks] = z;
                if (l15 < 4) qa[ks] = __builtin_nontemporal_load((const bf16x8*)(Qp + (g * 4 + l15) * 128 + ks * 32 + 8 * q4));
            }
#pragma unroll 1
            for (int ck = 0; ck < 8; ++ck) {
                const int it = g * 8 + ck;
                *(uint4*)(ktile + kwofs[0]) = kr0; *(uint4*)(ktile + kwofs[1]) = kr1; *(uint4*)(ktile + kwofs[2]) = kr2; *(uint4*)(ktile + kwofs[3]) = kr3;
                *(uint4*)(ktile + kwofs[4]) = kr4; *(uint4*)(ktile + kwofs[5]) = kr5; *(uint4*)(ktile + kwofs[6]) = kr6; *(uint4*)(ktile + kwofs[7]) = kr7;
                if (it + 1 < 16) KGLOAD(it + 1)
                LDS_FENCE();
#pragma unroll
                for (int rb = 0; rb < 2; ++rb) {
                    f32x4 acc = {0.f, 0.f, 0.f, 0.f};
#pragma unroll
                    for (int sx = 0; sx < 4; ++sx) {
                        const bf16x8 kb = *(const bf16x8*)(ktile + krd[rb][sx]);
                        acc = __builtin_amdgcn_mfma_f32_16x16x32_bf16(qa[sx], kb, acc, 0, 0, 0);
                    }
                    if (lane < 16) {
                        const int kidx = ck * 32 + rb * 16 + lane;
                        const bool ok = kidx < nsel;
#pragma unroll
                        for (int r = 0; r < 4; ++r) lg[(g * 4 + r) * 256 + kidx] = ok ? acc[r] * scale : -INFINITY;
                    }
                }
                LDS_FENCE();
            }
        }
#undef KGLOAD
#undef KLD1
    }
    LDS_FENCE();
    {
        uint2 pk[8];
#pragma unroll
        for (int hh = 0; hh < 8; ++hh) {
            const float4 x = *(const float4*)(lg + hh * 256 + 4 * lane);
            float m = wave_max_fast(fmaxf(fmaxf(x.x, x.y), fmaxf(x.z, x.w)));
            const float e0 = __expf(x.x - m), e1 = __expf(x.y - m), e2 = __expf(x.z - m), e3 = __expf(x.w - m);
            const float inv = 1.f / wave_sum_fast(e0 + e1 + e2 + e3);
            pk[hh].x = pack2(e0 * inv, e1 * inv);
            pk[hh].y = pack2(e2 * inv, e3 * inv);
        }
        LDS_FENCE();
#pragma unroll
        for (int hh = 0; hh < 8; ++hh) *(uint2*)(scr + hh * 512 + lane * 8) = pk[hh];
    }
    }
    LDS_FENCE();
    for (int rep4 = 0; rep4 < (PROBE_SEC == 4 ? 2 : 1); ++rep4) {
        unsigned char* vt = scr + 8192;
        const int q = l15 >> 2, p = l15 & 3;
        unsigned tra[8][2];
#pragma unroll
        for (int c = 0; c < 8; ++c)
#pragma unroll
            for (int tt = 0; tt < 2; ++tt) {
                const unsigned row = 8 * q4 + 4 * tt + q, ch = 2 * c + (p >> 1);
                tra[c][tt] = 256u * row + 16u * (ch ^ (((row & 3) << 2) | ((row >> 2) & 3))) + 8 * (p & 1);
            }
        unsigned wofs[8];
#pragma unroll
        for (int i = 0; i < 8; ++i) {
            const unsigned row = q4 + 4 * i, ch = l15;
            wofs[i] = 256u * row + 16u * (ch ^ (((row & 3) << 2) | ((row >> 2) & 3)));
        }
        uint4 vr0, vr1, vr2, vr3, vr4, vr5, vr6, vr7;
#define VLD1(i, dst) { const int key = idxl[ck_ * 32 + q4 + 4 * (i)]; dst = *(const uint4*)(Vb + (size_t)key * 256 + g_ * 128 + l15 * 8); }
#define VLOAD(it_) { const int g_ = (it_) >> 3, ck_ = (it_) & 7; VLD1(0, vr0) VLD1(1, vr1) VLD1(2, vr2) VLD1(3, vr3) VLD1(4, vr4) VLD1(5, vr5) VLD1(6, vr6) VLD1(7, vr7) }
        VLOAD(0)
        const u16* za = (const u16*)(ws + O_ZA) + (size_t)t * 1024;
        u16* ya = (u16*)(ws + O_YATT) + (size_t)t * 1024;
#pragma unroll 1
        for (int g = 0; g < 2; ++g) {
            f32x4 oacc[8];
#pragma unroll
            for (int c = 0; c < 8; ++c) { f32x4 z = {0.f, 0.f, 0.f, 0.f}; oacc[c] = z; }
#pragma unroll 1
            for (int ck = 0; ck < 8; ++ck) {
                const int it = g * 8 + ck;
                *(uint4*)(vt + wofs[0]) = vr0; *(uint4*)(vt + wofs[1]) = vr1; *(uint4*)(vt + wofs[2]) = vr2; *(uint4*)(vt + wofs[3]) = vr3;
                *(uint4*)(vt + wofs[4]) = vr4; *(uint4*)(vt + wofs[5]) = vr5; *(uint4*)(vt + wofs[6]) = vr6; *(uint4*)(vt + wofs[7]) = vr7;
                if (it + 1 < 16) VLOAD(it + 1)
                LDS_FENCE();
                const bf16x8 pa = *(const bf16x8*)(scr + (g * 4 + l15) * 512 + (ck * 32 + 8 * q4) * 2);
#pragma unroll
                for (int c = 0; c < 8; ++c) {
                    typedef short s16x4 __attribute__((ext_vector_type(4)));
                    const s16x4 lo = __builtin_amdgcn_ds_read_tr16_b64_v4i16((__attribute__((address_space(3))) s16x4*)(vt + tra[c][0]));
                    const s16x4 hi = __builtin_amdgcn_ds_read_tr16_b64_v4i16((__attribute__((address_space(3))) s16x4*)(vt + tra[c][1]));
                    const bf16x8 vb = {lo[0], lo[1], lo[2], lo[3], hi[0], hi[1], hi[2], hi[3]};
                    oacc[c] = __builtin_amdgcn_mfma_f32_16x16x32_bf16(pa, vb, oacc[c], 0, 0, 0);
                }
                LDS_FENCE();
            }
            if (lane < 16) {
#pragma unroll
                for (int c = 0; c < 8; ++c)
#pragma unroll
                    for (int r = 0; r < 4; ++r) {
                        const int cb = (g * 4 + r) * 128 + c * 16 + lane;
                        __builtin_nontemporal_store(f2bf(oacc[c][r] * bf2f(__builtin_nontemporal_load(za + cb))), ya + cb);
                    }
            }
        }
#undef VLOAD
#undef VLD1
    }
    __syncthreads();
}

DEV void phaseD(const Params& P, unsigned char* smem) {
    const int wid = threadIdx.x >> 6;
    const int G = gridDim.x;
    const bool s5_last = (blockIdx.x >> 3) & 1;
    if (!s5_last) {
        for (int job = blockIdx.x; job < 512; job += G) {
            const int unit = job * 4 + wid;
            for (int rep5 = 0; rep5 < (PROBE_SEC == 5 ? 2 : 1); ++rep5) s5_unit<true>(P, unit & 63, unit >> 6, smem + wid * 16896);
            __syncthreads();
        }
    }
    for (int aj = blockIdx.x; aj < 2048; aj += G) attn_job(P, aj, aj / G, smem);
    if (s5_last) {
        for (int job = blockIdx.x; job < 512; job += G) {
            const int unit = job * 4 + wid;
            s5_unit<true>(P, unit & 63, unit >> 6, smem + wid * 16896);
            __syncthreads();
        }
    }
}

DEV void phaseE(const Params& P, unsigned char* smem) {
    ACC_IDS
    unsigned char* ws = P.ws;
    for (int job = blockIdx.x; job < 1024; job += gridDim.x) {
        const int mt = job & 63, nt = job >> 6, m0 = mt * 128;
        f32x16 acc[2][2];
        ZERO_ACC(acc);
        gemm_mainloop((const u16*)(ws + O_YACT) + (size_t)m0 * 1024, 1024, (const u16*)(ws + O_WGLU) + (size_t)nt * 128 * 1024, 1024, 1024, smem, acc);
        const u16* zs = (const u16*)(ws + O_ZS);
        u16* ys = (u16*)(ws + O_U);
        float* st = (float*)smem;
        uint4 zpre[2][2];
#pragma unroll
        for (int mi = 0; mi < 2; ++mi)
#pragma unroll
            for (int i = 0; i < 2; ++i) {
                const int cid = threadIdx.x + 256 * i, sr = cid >> 3, ac = cid & 7;
                zpre[mi][i] = *(const uint4*)(zs + (size_t)(m0 + SR_TO_ROW(sr, mi)) * 1024 + nt * 64 + (ac >> 2) * 32 + (ac & 3) * 8);
            }
#pragma unroll
        for (int mi = 0; mi < 2; ++mi) {
            stage_half(acc, mi, st);
#pragma unroll
            for (int i = 0; i < 2; ++i) {
                const int cid = threadIdx.x + 256 * i;
                const int sr = cid >> 3, ac = cid & 7;
                const int tcol = (ac >> 2) * 64 + (ac & 3) * 8;
                const int row = m0 + SR_TO_ROW(sr, mi);
                const int ocol = nt * 64 + (ac >> 2) * 32 + (ac & 3) * 8;
                const float4 a0 = *(const float4*)(st + sr * 132 + tcol), a1 = *(const float4*)(st + sr * 132 + tcol + 4);
                const float4 b0 = *(const float4*)(st + sr * 132 + tcol + 32), b1 = *(const float4*)(st + sr * 132 + tcol + 36);
                float z[8];
                unpack8(zpre[mi][i], z);
                float o[8];
                o[0] = a0.x * sigmoidf_(b0.x) * z[0]; o[1] = a0.y * sigmoidf_(b0.y) * z[1]; o[2] = a0.z * sigmoidf_(b0.z) * z[2]; o[3] = a0.w * sigmoidf_(b0.w) * z[3];
                o[4] = a1.x * sigmoidf_(b1.x) * z[4]; o[5] = a1.y * sigmoidf_(b1.y) * z[5]; o[6] = a1.z * sigmoidf_(b1.z) * z[6]; o[7] = a1.w * sigmoidf_(b1.w) * z[7];
                *(uint4*)(ys + (size_t)row * 1024 + ocol) = pack8(o);
            }
            __syncthreads();
        }
    }
}

DEV void phaseF(const Params& P, unsigned char* smem) {
    ACC_IDS
    unsigned char* ws = P.ws;
    const int ntile = (1024 - (int)blockIdx.x + (int)gridDim.x - 1) / (int)gridDim.x;
    uint4 part[2][4];
    for (int q = 0; q < 2 * ntile; ++q) {
        const int job = blockIdx.x + (q >> 1) * gridDim.x, pass = q & 1;
        const int mt = job & 63, nt = job >> 6, m0 = mt * 128, n0 = nt * 128;
        f32x16 acc[2][2];
        ZERO_ACC(acc);
        const u16* A = (const u16*)(ws + (pass ? O_YATT : O_U)) + (size_t)m0 * 1024;
        const u16* B = (const u16*)(ws + (pass ? O_WATTO : O_WSSMO)) + (size_t)n0 * 1024;
        gemm_mainloop(A, 1024, B, 1024, 1024, smem, acc);
        const u16* gt = (const u16*)(ws + (pass ? O_GA : O_GS));
        u16* mg = (u16*)(ws + O_MERGED);
        float* st = (float*)smem;
        uint4 gpre[2][4];
#pragma unroll
        for (int mi = 0; mi < 2; ++mi)
#pragma unroll
            for (int i_ = 0; i_ < 4; ++i_) {
                const int cid_ = threadIdx.x + 256 * i_, sr_ = cid_ >> 4, col0_ = (cid_ & 15) * 8;
                gpre[mi][i_] = *(const uint4*)(gt + (size_t)(m0 + SR_TO_ROW(sr_, mi)) * 2048 + n0 + col0_);
            }
#pragma unroll
        for (int mi = 0; mi < 2; ++mi) {
            stage_half(acc, mi, st);
#pragma unroll
            for (int i_ = 0; i_ < 4; ++i_) {
                CHUNK_LOAD(st)
                const size_t o = (size_t)(m0 + SR_TO_ROW(sr_, mi)) * 2048 + n0 + col0_;
                float g[8];
                unpack8(gpre[mi][i_], g);
                _Pragma("unroll") for (int e = 0; e < 8; ++e) v_[e] *= g[e];
                if (pass) {
                    float pvv[8];
                    unpack8(part[mi][i_], pvv);
                    _Pragma("unroll") for (int e = 0; e < 8; ++e) v_[e] += pvv[e];
                    *(uint4*)(mg + o) = pack8(v_);
                } else {
                    part[mi][i_] = pack8(v_);
                }
            }
            __syncthreads();
        }
    }
}

DEV void phaseG(const Params& P, unsigned char* smem) {
    ACC_IDS
    unsigned char* ws = P.ws;
    for (int job = blockIdx.x; job < 1024; job += gridDim.x) {
        const int mt = job & 63, nt = job >> 6, m0 = mt * 128, n0 = nt * 128;
        f32x16 acc[2][2];
        ZERO_ACC(acc);
        gemm_mainloop((const u16*)(ws + O_MERGED) + (size_t)m0 * 2048, 2048, (const u16*)(ws + O_WO) + (size_t)n0 * 2048, 2048, 2048, smem, acc);
        u16* xb = (u16*)(ws + O_X1B);
        float* ssq = (float*)(ws + O_SSQ1);
        float* st = (float*)smem;
#pragma unroll 1
        for (int mi = 0; mi < 2; ++mi) {
            stage_half(acc, mi, st);
            FOR_CHUNKS(st) {
                CHUNK_LOAD(st)
                const int row = m0 + SR_TO_ROW(sr_, mi);
                const size_t o = (size_t)row * 2048 + n0 + col0_;
                const float4 x0 = ld_nt16f(P.x + o), x1 = ld_nt16f(P.x + o + 4);
                v_[0] += x0.x; v_[1] += x0.y; v_[2] += x0.z; v_[3] += x0.w; v_[4] += x1.x; v_[5] += x1.y; v_[6] += x1.z; v_[7] += x1.w;
                st_nt16f(P.out + o, make_float4(v_[0], v_[1], v_[2], v_[3]));
                st_nt16f(P.out + o + 4, make_float4(v_[4], v_[5], v_[6], v_[7]));
                st_nt16(xb + o, pack8(v_));
                float ss = 0.f;
                _Pragma("unroll") for (int e = 0; e < 8; ++e) ss += v_[e] * v_[e];
                ss += __shfl_xor(ss, 1); ss += __shfl_xor(ss, 2); ss += __shfl_xor(ss, 4); ss += __shfl_xor(ss, 8);
                if ((threadIdx.x & 15) == 0) ssq[(size_t)row * 16 + nt] = ss;
            }
            __syncthreads();
        }
    }
}

DEV void phaseH(const Params& P, unsigned char* smem) {
    ACC_IDS
    const int tid = threadIdx.x;
    unsigned char* ws = P.ws;
    float* rinv_s = (float*)(smem + 65536);
    for (int job = blockIdx.x; job < 2048; job += gridDim.x) {
        const int jj = job & 1023;
        const int mt = jj & 63, nt = jj >> 6, m0 = mt * 128, n0 = nt * 128;
        f32x16 acc[2][2];
        ZERO_ACC(acc);
        if (job < 1024) {
            {
                const int row = tid >> 1, half = tid & 1;
                const float4* sp = (const float4*)((const float*)(ws + O_SSQ1) + (size_t)(m0 + row) * 16 + half * 8);
                float ss = 0.f;
#pragma unroll
                for (int i = 0; i < 2; ++i) { const float4 q = sp[i]; ss += q.x + q.y + q.z + q.w; }
                ss += __shfl_xor(ss, 1);
                if (half == 0) rinv_s[row] = rsqrtf(ss * (1.f / 2048.f) + 1e-6f);
            }
            gemm_mainloop((const u16*)(ws + O_X1B) + (size_t)m0 * 2048, 2048, (const u16*)(ws + O_WPG) + (size_t)n0 * 2048, 2048, 2048, smem, acc);
            u16* gt = (u16*)(ws + O_GS);
            float* st = (float*)smem;
#pragma unroll 1
            for (int mi = 0; mi < 2; ++mi) {
                stage_half(acc, mi, st);
                FOR_CHUNKS(st) {
                    CHUNK_LOAD(st)
                    const int rl = SR_TO_ROW(sr_, mi);
                    const float ri = rinv_s[rl];
                    _Pragma("unroll") for (int e = 0; e < 8; ++e) v_[e] = sigmoidf_(v_[e] * ri);
                    st_nt16(gt + (size_t)(m0 + rl) * 2048 + n0 + col0_, pack8(v_));
                }
                __syncthreads();
            }
        } else {
            gemm_mainloop((const u16*)(ws + O_PBF) + (size_t)m0 * 256, 256, (const u16*)(ws + O_WPLE) + (size_t)n0 * 256, 256, 256, smem, acc);
            u16* er = (u16*)(ws + O_GA);
            float* ssq = (float*)(ws + O_SSQE);
            float* st = (float*)smem;
#pragma unroll 1
            for (int mi = 0; mi < 2; ++mi) {
                stage_half(acc, mi, st);
                FOR_CHUNKS(st) {
                    CHUNK_LOAD(st)
                    const int row = m0 + SR_TO_ROW(sr_, mi);
                    st_nt16(er + (size_t)row * 2048 + n0 + col0_, pack8(v_));
                    float ss = 0.f;
                    _Pragma("unroll") for (int e = 0; e < 8; ++e) ss += v_[e] * v_[e];
                    ss += __shfl_xor(ss, 1); ss += __shfl_xor(ss, 2); ss += __shfl_xor(ss, 4); ss += __shfl_xor(ss, 8);
                    if ((threadIdx.x & 15) == 0) ssq[(size_t)row * 16 + nt] = ss;
                }
                __syncthreads();
            }
        }
    }
}

DEV void phaseI(const Params& P, unsigned char* smem) {
    const int tid = threadIdx.x, lane = tid & 63, wid = tid >> 6;
    unsigned char* ws = P.ws;
    for (int job = blockIdx.x; job < 2048; job += gridDim.x) {
        const int row = job * 4 + wid;
        float sse = (lane < 16) ? ((const float*)(ws + O_SSQE))[(size_t)row * 16 + lane] : 0.f;
        sse = wave_sum(sse);
        const float rinv_e = rsqrtf(sse * (1.f / 2048.f) + 1e-6f);
        float4* xo = (float4*)(P.out + (size_t)row * 2048);
        const uint2* gt = (const uint2*)((const u16*)(ws + O_GS) + (size_t)row * 2048);
        const uint2* er = (const uint2*)((const u16*)(ws + O_GA) + (size_t)row * 2048);
        const float4* gp = (const float4*)P.g_ple_post;
        const float4* gf = (const float4*)P.g_final;
        float4 v[8];
        float ss = 0.f;
#pragma unroll
        for (int i = 0; i < 8; ++i) {
            const int c = lane + 64 * i;
            const float4 x1 = xo[c];
            const uint2 g2 = gt[c], e2 = er[c];
            const float4 gg = gp[c];
            float4 o;
            o.x = x1.x + __uint_as_float(g2.x << 16) * (__uint_as_float(e2.x << 16) * rinv_e * gg.x);
            o.y = x1.y + __uint_as_float(g2.x & 0xFFFF0000u) * (__uint_as_float(e2.x & 0xFFFF0000u) * rinv_e * gg.y);
            o.z = x1.z + __uint_as_float(g2.y << 16) * (__uint_as_float(e2.y << 16) * rinv_e * gg.z);
            o.w = x1.w + __uint_as_float(g2.y & 0xFFFF0000u) * (__uint_as_float(e2.y & 0xFFFF0000u) * rinv_e * gg.w);
            v[i] = o;
            ss += o.x * o.x + o.y * o.y + o.z * o.z + o.w * o.w;
        }
        ss = wave_sum(ss);
        const float rinv = rsqrtf(ss * (1.f / 2048.f) + 1e-6f);
#pragma unroll
        for (int i = 0; i < 8; ++i) {
            const int c = lane + 64 * i;
            const float4 g = gf[c];
            xo[c] = make_float4(v[i].x * rinv * g.x, v[i].y * rinv * g.y, v[i].z * rinv * g.z, v[i].w * rinv * g.w);
        }
    }
}

#define XB_TMO      128
#define XB_XCNT(j)  (256  + 64 * (j))
#define XB_XSUB(j)  (1280 + 64 * (j))
#define XB_XGEN(j)  (2304 + 64 * (j))
#define XB_TOP      3328
#define XB_TOPGEN   3392
#define XCD_BAR_WORDS 3456
#define XB_SPIN_CAP (1u << 18)
#define LAS __attribute__((address_space(3)))

__device__ __forceinline__ unsigned xb_ld(unsigned* p)              { return __hip_atomic_load(p, __ATOMIC_RELAXED, __HIP_MEMORY_SCOPE_AGENT); }
__device__ __forceinline__ unsigned xb_add(unsigned* p, unsigned v) { return __hip_atomic_fetch_add(p, v, __ATOMIC_RELAXED, __HIP_MEMORY_SCOPE_AGENT); }
__device__ __forceinline__ unsigned xb_xcc_id() { return (unsigned)__builtin_amdgcn_s_getreg((3 << 11) | 20) & 0xFu; }
#define XB_SPIN(cond, bar) do { unsigned _sp = 0; while (cond) { __builtin_amdgcn_s_sleep(1); \
    if ((++_sp & 255u) == 0u) { if (xb_ld(&(bar)[XB_TMO])) break; if (_sp > XB_SPIN_CAP) { atomicAdd(&(bar)[XB_TMO], 1u); break; } } } } while (0)

struct XcdBarrier {
    unsigned* bar; unsigned x;
    volatile LAS unsigned* st;
};

__device__ __forceinline__ XcdBarrier xcd_barrier_post(unsigned* bar, volatile LAS unsigned* st) {
    XcdBarrier b; b.bar = bar; b.x = xb_xcc_id(); b.st = st;
    if (threadIdx.x == 0) (void)xb_add(&bar[XB_XCNT(b.x)], 1u);
    return b;
}
__device__ __forceinline__ void xcd_barrier_complete(unsigned* bar, unsigned x, unsigned& nloc, unsigned& nx) {
    const unsigned G = gridDim.x * gridDim.y * gridDim.z;
    unsigned sum, cnt, mine, sp = 0u;
    for (;;) {
        sum = 0u; cnt = 0u; mine = 0u;
#pragma unroll
        for (unsigned j = 0; j < 16; ++j) { const unsigned c = xb_ld(&bar[XB_XCNT(j)]); sum += c; cnt += (c > 0u) ? 1u : 0u; mine = (j == x) ? c : mine; }
        if (sum == G) break;
        __builtin_amdgcn_s_sleep(1);
        if ((++sp & 255u) == 0u) { if (xb_ld(&bar[XB_TMO])) break; if (sp > XB_SPIN_CAP) { atomicAdd(&bar[XB_TMO], 1u); break; } }
    }
    nloc = mine > 0u ? mine : 1u; nx = cnt > 0u ? cnt : 1u;
}

__device__ __forceinline__ void xcd_barrier(const XcdBarrier& b) {
    asm volatile("s_waitcnt vmcnt(0)" ::: "memory");
    __syncthreads();
    if (threadIdx.x == 0) {
        unsigned* bar = b.bar;
        __builtin_amdgcn_s_waitcnt(0);
        unsigned nloc = b.st[0], nx = b.st[1];
        if (nloc == 0u) { xcd_barrier_complete(bar, b.x, nloc, nx); b.st[0] = nloc; b.st[1] = nx; }
        const unsigned old = xb_add(&bar[XB_XSUB(b.x)], 1u);
        const unsigned gen = old / nloc;
        if (old + 1u == (gen + 1u) * nloc) {
            __builtin_amdgcn_fence(__ATOMIC_RELEASE, "agent");
            asm volatile("s_waitcnt vmcnt(0)" ::: "memory");
            const unsigned og = xb_add(&bar[XB_TOP], 1u);
            const unsigned tg = og / nx;
            if (og + 1u == (tg + 1u) * nx) xb_add(&bar[XB_TOPGEN], 1u);
            else XB_SPIN(xb_ld(&bar[XB_TOPGEN]) == tg, bar);
            __builtin_amdgcn_fence(__ATOMIC_ACQUIRE, "agent");
            xb_add(&bar[XB_XGEN(b.x)], 1u);
            asm volatile("s_waitcnt vmcnt(0)" ::: "memory");
        } else {
            XB_SPIN(xb_ld(&bar[XB_XGEN(b.x)]) == gen, bar);
            __builtin_amdgcn_fence(__ATOMIC_ACQUIRE, "agent");
            asm volatile("s_waitcnt vmcnt(0)" ::: "memory");
        }
    }
    __syncthreads();
}


__global__ void __launch_bounds__(256, 2) mega(Params P) {
    extern __shared__ __align__(16) unsigned char smem[];
    cg::grid_group grid = cg::this_grid();
    const int lo = P.ph_lo, hi = P.ph_hi;
    volatile LAS unsigned* xst = (volatile LAS unsigned*)(smem + LDS_BYTES - 16);
    if (threadIdx.x == 0) { xst[0] = 0u; xst[1] = 0u; }
    __syncthreads();
    const XcdBarrier xb = xcd_barrier_post((unsigned*)(P.ws + O_BAR), xst);
    if (lo < 0) grid.sync();
    if (lo <= 0 && 0 < hi) phaseA(P, smem);
#if PROBE_DUP == 0
    xcd_barrier(xb); phaseA(P, smem);
#endif
    if (lo < 1 && 1 < hi) xcd_barrier(xb);
    if (lo <= 1 && 1 < hi) phaseB(P, smem);
#if PROBE_DUP == 1
    xcd_barrier(xb); phaseB(P, smem);
#endif
    if (lo < 2 && 2 < hi) xcd_barrier(xb);
    if (lo <= 2 && 2 < hi) phaseC(P, smem);
#if PROBE_DUP == 2
    xcd_barrier(xb); phaseC(P, smem);
#endif
    if (lo < 3 && 3 < hi) xcd_barrier(xb);
    if (lo <= 3 && 3 < hi) phaseD(P, smem);
#if PROBE_DUP == 3
    xcd_barrier(xb); phaseD(P, smem);
#endif
    if (lo < 4 && 4 < hi) xcd_barrier(xb);
    if (lo <= 4 && 4 < hi) phaseE(P, smem);
#if PROBE_DUP == 4
    xcd_barrier(xb); phaseE(P, smem);
#endif
    if (lo < 5 && 5 < hi) xcd_barrier(xb);
    if (lo <= 5 && 5 < hi) phaseF(P, smem);
#if PROBE_DUP == 5
    xcd_barrier(xb); phaseF(P, smem);
#endif
    if (lo < 6 && 6 < hi) xcd_barrier(xb);
    if (lo <= 6 && 6 < hi) phaseG(P, smem);
#if PROBE_DUP == 6
    xcd_barrier(xb); phaseG(P, smem);
#endif
    if (lo < 7 && 7 < hi) xcd_barrier(xb);
    if (lo <= 7 && 7 < hi) phaseH(P, smem);
#if PROBE_DUP == 7
    xcd_barrier(xb); phaseH(P, smem);
#endif
    if (lo < 8 && 8 < hi) xcd_barrier(xb);
    if (lo <= 8 && 8 < hi) phaseI(P, smem);
}

extern "C" void kernel_launch(void* const* d_in, const int* in_sizes, int n_in, void* d_out, int out_size,
                              void* d_ws, size_t ws_size, hipStream_t stream) {
    static int grid_blocks = 0;
    if (!grid_blocks) {
        if (n_in != 25 || ws_size < WS_END) { fprintf(stderr, "kernel_launch: unexpected n_in %d / ws %zu (need %zu)\n", n_in, ws_size, (size_t)WS_END); grid_blocks = -1; return; }
        int dev = 0, cus = 0, per_cu = 0;
        hipGetDevice(&dev);
        hipDeviceGetAttribute(&cus, hipDeviceAttributeMultiprocessorCount, dev);
        hipFuncSetAttribute((const void*)mega, hipFuncAttributeMaxDynamicSharedMemorySize, LDS_BYTES);
        hipOccupancyMaxActiveBlocksPerMultiprocessor(&per_cu, (const void*)mega, 256, LDS_BYTES);
        if (per_cu < 1) per_cu = 1;
        if (per_cu > 2) per_cu = 2;
        grid_blocks = cus * per_cu;
    }
    if (grid_blocks < 0) return;
    Params p{};
    const float** f = (const float**)&p;
    for (int i = 0; i < 25; ++i) f[i] = (const float*)d_in[i];
    p.out = (float*)d_out;
    p.ws = (unsigned char*)d_ws;
    (void)hipMemsetAsync((unsigned char*)d_ws + O_BAR, 0, XCD_BAR_WORDS * sizeof(unsigned), stream);
#if N_LAUNCH_MODE == 1
    p.ph_lo = 0; p.ph_hi = NPHASE;
    void* args[] = {&p};
    hipError_t e = hipLaunchCooperativeKernel((const void*)mega, dim3(grid_blocks), dim3(256), args, LDS_BYTES, stream);
    if (e != hipSuccess) fprintf(stderr, "cooperative launch failed: %s (grid %d)\n", hipGetErrorString(e), grid_blocks);
#else
    for (int ph = 0; ph < NPHASE; ++ph) {
        p.ph_lo = ph; p.ph_hi = ph + 1;
        hipLaunchKernelGGL(mega, dim3(grid_blocks), dim3(256), LDS_BYTES, stream, p);
    }
#endif
}
```

```cpp
#include <hip/hip_runtime.h>
#include <hip/hip_cooperative_groups.h>
#include <stdint.h>
#include <stdio.h>
namespace cg = cooperative_groups;

#ifndef PROBE_DUP
#define PROBE_DUP -1
#endif
#ifndef PROBE_SEC
#define PROBE_SEC 0
#endif
#ifndef N_LAUNCH_MODE
#define N_LAUNCH_MODE 1
#endif

typedef unsigned short u16;
typedef short bf16x8 __attribute__((ext_vector_type(8)));
typedef float f32x16 __attribute__((ext_vector_type(16)));
typedef float f32x4 __attribute__((ext_vector_type(4)));

#define DEV __device__ __forceinline__
#define LDS_FENCE() asm volatile("s_waitcnt lgkmcnt(0)" ::: "memory")

constexpr int NPHASE = 9;
constexpr int LDS_BYTES = 70656;

constexpr size_t O_WIN = 0;
constexpr size_t O_YACT = 0;
constexpr size_t O_YATT = 16777216;
constexpr size_t O_WUQ = 34078720;
constexpr size_t O_WGLU = O_WUQ + 2097152;
constexpr size_t O_WSSMO = O_WGLU + 4194304;
constexpr size_t O_WATTO = O_WSSMO + 4194304;
constexpr size_t O_WO = O_WATTO + 4194304;
constexpr size_t O_WPG = O_WO + 8388608;
constexpr size_t O_WPLE = O_WPG + 8388608;
constexpr size_t O_H = O_WPLE + 1048576;
constexpr size_t O_Q = O_H;
constexpr size_t O_QIDX = O_H + 16777216;
constexpr size_t O_MERGED = O_H;
constexpr size_t O_U = O_H + 33554432;
constexpr size_t O_ZS = O_U + 16777216;
constexpr size_t O_X1B = O_U;
constexpr size_t O_CQ = O_ZS + 16777216;
constexpr size_t O_K = O_CQ + 8388608;
constexpr size_t O_V = O_K + 4194304;
constexpr size_t O_ZA = O_V + 4194304;
constexpr size_t O_GS = O_ZA + 16777216;
constexpr size_t O_GA = O_GS + 33554432;
constexpr size_t O_KIDXRAW = O_GA + 33554432;
constexpr size_t O_KIDX = O_KIDXRAW + 2097152;
constexpr size_t O_WIDX = O_KIDX + 1048576;
constexpr size_t O_PBF = O_WIDX + 524288;
constexpr size_t O_ABAR = O_PBF + 4194304;
constexpr size_t O_ABART = O_ABAR + 32768;
constexpr size_t O_BBT = O_ABART + 32768;
constexpr size_t O_CCT = O_BBT + 262144;
constexpr size_t O_ENDST = O_CCT + 524288;
constexpr size_t O_SSQ1 = O_ENDST + 1048576;
constexpr size_t O_SSQE = O_SSQ1 + 1048576;
constexpr size_t O_SSQC = O_SSQE + 1048576;
constexpr size_t O_BAR = O_SSQC + 131072;
constexpr size_t WS_END = O_BAR + 16384;

struct Params {
    const float *x, *p, *g_mix, *w_in, *g_q, *w_uq, *w_uq_idx, *g_kidx, *a_re, *a_im, *log_dt, *b_re, *b_im,
        *c_re, *c_im, *d_skip, *w_glu, *w_ssm_out, *w_attn_out, *w_o, *g_ple, *w_ple_gate, *w_ple, *g_ple_post, *g_final;
    float* out;
    unsigned char* ws;
    int ph_lo, ph_hi;
};

DEV u16 f2bf(float f) { uint32_t u = __float_as_uint(f); u += 0x7FFFu + ((u >> 16) & 1u); return (u16)(u >> 16); }
DEV float bf2f(u16 h) { return __uint_as_float(((uint32_t)h) << 16); }
DEV uint32_t pack2(float a, float b) { return (uint32_t)f2bf(a) | ((uint32_t)f2bf(b) << 16); }
DEV float sigmoidf_(float x) { return 1.f / (1.f + __expf(-x)); }
DEV float siluf_(float x) { return x / (1.f + __expf(-x)); }
DEV float geluf_(float x) { float u = 0.7978845608028654f * (x + 0.044715f * x * x * x); return x - x / (1.f + __expf(2.f * u)); }
DEV float wave_sum(float v) { for (int d = 32; d >= 1; d >>= 1) v += __shfl_xor(v, d); return v; }
#define DPPF_(v, ctrl) __int_as_float(__builtin_amdgcn_mov_dpp(__float_as_int(v), ctrl, 0xF, 0xF, true))
DEV float wave_max_fast(float v) {
    v = fmaxf(v, DPPF_(v, 0xB1)); v = fmaxf(v, DPPF_(v, 0x4E)); v = fmaxf(v, DPPF_(v, 0x141)); v = fmaxf(v, DPPF_(v, 0x140));
    const float r0 = __int_as_float(__builtin_amdgcn_readlane(__float_as_int(v), 0)), r1 = __int_as_float(__builtin_amdgcn_readlane(__float_as_int(v), 16));
    const float r2 = __int_as_float(__builtin_amdgcn_readlane(__float_as_int(v), 32)), r3 = __int_as_float(__builtin_amdgcn_readlane(__float_as_int(v), 48));
    return fmaxf(fmaxf(r0, r1), fmaxf(r2, r3));
}
DEV float wave_sum_fast(float v) {
    v += DPPF_(v, 0xB1); v += DPPF_(v, 0x4E); v += DPPF_(v, 0x141); v += DPPF_(v, 0x140);
    const float r0 = __int_as_float(__builtin_amdgcn_readlane(__float_as_int(v), 0)), r1 = __int_as_float(__builtin_amdgcn_readlane(__float_as_int(v), 16));
    const float r2 = __int_as_float(__builtin_amdgcn_readlane(__float_as_int(v), 32)), r3 = __int_as_float(__builtin_amdgcn_readlane(__float_as_int(v), 48));
    return (r0 + r1) + (r2 + r3);
}
DEV float wave_max(float v) { for (int d = 32; d >= 1; d >>= 1) v = fmaxf(v, __shfl_xor(v, d)); return v; }

DEV void gemm_mainloop(const u16* __restrict__ A, int lda, const u16* __restrict__ B, int ldb, int K,
                       unsigned char* smem, f32x16 (&acc)[2][2]) {
    const int tid = threadIdx.x, lane = tid & 63, wid = tid >> 6;
    const int wm = wid >> 1, wn = wid & 1;
    const int lrow = tid >> 3, lslot = tid & 7;
    uint4 pa0, pa1, pa2, pa3, pb0, pb1, pb2, pb3;
    uint4 qa0, qa1, qa2, qa3, qb0, qb1, qb2, qb3;
    const u16* Ap = A + (size_t)lrow * lda + lslot * 8;
    const u16* Bp = B + (size_t)lrow * ldb + lslot * 8;
    const size_t a32 = (size_t)32 * lda, b32 = (size_t)32 * ldb;
    const int woff = lrow * 128 + ((lslot ^ ((lrow >> 1) & 7)) << 4);
#define GLOAD(S, k0) { S##a0 = *(const uint4*)(Ap + (k0)); S##a1 = *(const uint4*)(Ap + a32 + (k0)); S##a2 = *(const uint4*)(Ap + 2 * a32 + (k0)); S##a3 = *(const uint4*)(Ap + 3 * a32 + (k0)); \
                       S##b0 = *(const uint4*)(Bp + (k0)); S##b1 = *(const uint4*)(Bp + b32 + (k0)); S##b2 = *(const uint4*)(Bp + 2 * b32 + (k0)); S##b3 = *(const uint4*)(Bp + 3 * b32 + (k0)); }
#define SWRITE(S, buf) { unsigned char* as_ = smem + (buf) * 16384 + woff; unsigned char* bs_ = smem + 32768 + (buf) * 16384 + woff; \
                      *(uint4*)(as_) = S##a0; *(uint4*)(as_ + 4096) = S##a1; *(uint4*)(as_ + 8192) = S##a2; *(uint4*)(as_ + 12288) = S##a3; \
                      *(uint4*)(bs_) = S##b0; *(uint4*)(bs_ + 4096) = S##b1; *(uint4*)(bs_ + 8192) = S##b2; *(uint4*)(bs_ + 12288) = S##b3; }
    const int nk = K >> 6;
    const int rA = wm * 64 + (lane & 31), rB = wn * 64 + (lane & 31);
    const int swA = (rA >> 1) & 7, swB = (rB >> 1) & 7;
    const int h = lane >> 5;
#define FRAG(ks, a0, a1, b0, b1) const int slot##ks = (ks) * 2 + h; \
            const bf16x8 a0 = *(const bf16x8*)(as_ + ((slot##ks ^ swA) << 4)); const bf16x8 a1 = *(const bf16x8*)(as_ + 4096 + ((slot##ks ^ swA) << 4)); \
            const bf16x8 b0 = *(const bf16x8*)(bs_ + ((slot##ks ^ swB) << 4)); const bf16x8 b1 = *(const bf16x8*)(bs_ + 4096 + ((slot##ks ^ swB) << 4));
#define MM(a0, a1, b0, b1) acc[0][0] = __builtin_amdgcn_mfma_f32_32x32x16_bf16(a0, b0, acc[0][0], 0, 0, 0); acc[0][1] = __builtin_amdgcn_mfma_f32_32x32x16_bf16(a0, b1, acc[0][1], 0, 0, 0); \
            acc[1][0] = __builtin_amdgcn_mfma_f32_32x32x16_bf16(a1, b0, acc[1][0], 0, 0, 0); acc[1][1] = __builtin_amdgcn_mfma_f32_32x32x16_bf16(a1, b1, acc[1][1], 0, 0, 0);
#define COMPUTE(cur) { const unsigned char* as_ = smem + (cur) * 16384 + rA * 128; const unsigned char* bs_ = smem + 32768 + (cur) * 16384 + rB * 128; \
        FRAG(0, fa00, fa01, fb00, fb01) FRAG(1, fa10, fa11, fb10, fb11) FRAG(2, fa20, fa21, fb20, fb21) FRAG(3, fa30, fa31, fb30, fb31) \
        MM(fa00, fa01, fb00, fb01) MM(fa10, fa11, fb10, fb11) MM(fa20, fa21, fb20, fb21) MM(fa30, fa31, fb30, fb31) \
        __builtin_amdgcn_sched_group_barrier(0x100, 8, 0); __builtin_amdgcn_sched_group_barrier(0x008, 4, 0); \
        __builtin_amdgcn_sched_group_barrier(0x100, 4, 0); __builtin_amdgcn_sched_group_barrier(0x008, 4, 0); \
        __builtin_amdgcn_sched_group_barrier(0x100, 4, 0); __builtin_amdgcn_sched_group_barrier(0x008, 8, 0); }
    GLOAD(p, 0);
    GLOAD(q, 64);
    SWRITE(p, 0);
    __syncthreads();
    for (int kt = 0; kt < nk; kt += 2) {
        if (kt + 2 < nk) GLOAD(p, (kt + 2) * 64);
        COMPUTE(0);
        SWRITE(q, 1);
        __syncthreads();
        if (kt + 3 < nk) GLOAD(q, (kt + 3) * 64);
        COMPUTE(1);
        if (kt + 2 < nk) SWRITE(p, 0);
        __syncthreads();
    }
#undef GLOAD
#undef SWRITE
#undef COMPUTE
#undef FRAG
#undef MM
}

DEV void stage_half(const f32x16 (&acc)[2][2], int mi, float* st) {
    const int lane = threadIdx.x & 63, wid = threadIdx.x >> 6, wm = wid >> 1, wn = wid & 1;
#pragma unroll
    for (int ni = 0; ni < 2; ++ni)
#pragma unroll
        for (int r = 0; r < 16; ++r)
            st[(wm * 32 + (r & 3) + 8 * (r >> 2) + 4 * (lane >> 5)) * 132 + wn * 64 + ni * 32 + (lane & 31)] = mi ? acc[1][ni][r] : acc[0][ni][r];
    __syncthreads();
}
#define SR_TO_ROW(sr, mi) ((((sr) >> 5) << 6) + (mi) * 32 + ((sr) & 31))
typedef unsigned u32x4nt __attribute__((ext_vector_type(4)));
DEV uint4 ld_nt16(const void* p) { const u32x4nt t = __builtin_nontemporal_load((const u32x4nt*)p); return make_uint4(t[0], t[1], t[2], t[3]); }
DEV uint4 pack8(const float (&v)[8]) { uint4 o; o.x = pack2(v[0], v[1]); o.y = pack2(v[2], v[3]); o.z = pack2(v[4], v[5]); o.w = pack2(v[6], v[7]); return o; }
DEV void unpack8(const uint4 q, float (&v)[8]) {
    v[0] = __uint_as_float(q.x << 16); v[1] = __uint_as_float(q.x & 0xFFFF0000u); v[2] = __uint_as_float(q.y << 16); v[3] = __uint_as_float(q.y & 0xFFFF0000u);
    v[4] = __uint_as_float(q.z << 16); v[5] = __uint_as_float(q.z & 0xFFFF0000u); v[6] = __uint_as_float(q.w << 16); v[7] = __uint_as_float(q.w & 0xFFFF0000u);
}
#define FOR_CHUNKS(st) _Pragma("unroll") for (int i_ = 0; i_ < 4; ++i_)
#define CHUNK_LOAD(st) const int cid_ = threadIdx.x + 256 * i_; const int sr_ = cid_ >> 4, col0_ = (cid_ & 15) * 8; float v_[8]; \
    { const float4 x0_ = *(const float4*)((st) + sr_ * 132 + col0_), x1_ = *(const float4*)((st) + sr_ * 132 + col0_ + 4); \
      v_[0] = x0_.x; v_[1] = x0_.y; v_[2] = x0_.z; v_[3] = x0_.w; v_[4] = x1_.x; v_[5] = x1_.y; v_[6] = x1_.z; v_[7] = x1_.w; }

DEV int cbar_() { asm volatile("" ::: "memory"); return 0; }
#define ZERO_ACC(acc) { _Pragma("unroll") for (int i_ = 0; i_ < 2; ++i_) _Pragma("unroll") for (int j_ = 0; j_ < 2; ++j_) _Pragma("unroll") for (int r_ = 0; r_ < 16; ++r_) acc[i_][j_][r_] = 0.f; }
#define FOR_ACC _Pragma("unroll") for (int mi = 0; mi < 2; ++mi) _Pragma("unroll") for (int ni = 0; ni < 2; ++ni) _Pragma("unroll") for (int r = cbar_(); r < 16; ++r)
#define ACC_ROW (wm_ * 64 + mi * 32 + (r & 3) + 8 * (r >> 2) + 4 * (lane_ >> 5))
#define ACC_COL (wn_ * 64 + ni * 32 + (lane_ & 31))
#define ACC_IDS const int lane_ = threadIdx.x & 63, wm_ = (threadIdx.x >> 6) >> 1, wn_ = (threadIdx.x >> 6) & 1;

struct WcJob { const float* src; const float* ksc; u16* dst; int ld, c0, c1, nvalid, K, k0; };
DEV WcJob wconv_decode(const Params& P, int job) {
    unsigned char* ws = P.ws;
    const float* src; const float* ksc = nullptr; u16* dst; int ld, c0, c1, nvalid = 64, K, kt, n0;
    if (job < 2080) {
        n0 = (job >> 4) * 64; kt = job & 15; K = 2048; src = P.w_in; ld = 8272;
        if (n0 < 4096) c0 = n0; else if (n0 < 8192) c0 = n0 + 80; else { c0 = n0 - 8192 + 4096; nvalid = min(64, max(0, 8272 - n0)); }
        c1 = c0 + 32;
        dst = (u16*)(ws + O_WIN) + (size_t)n0 * 2048;
    } else if (job < 2208) {
        const int lt = job - 2080; n0 = (lt >> 2) * 64; kt = lt & 3; K = 512; ld = 1024; ksc = P.g_q;
        if (n0 < 1024) { src = P.w_uq; c0 = n0; } else { src = P.w_uq_idx; c0 = n0 - 1024; }
        c1 = c0 + 32;
        dst = (u16*)(ws + O_WUQ) + (size_t)n0 * 512;
    } else if (job < 2464) {
        const int lt = job - 2208; n0 = (lt >> 3) * 64; kt = lt & 7; K = 1024; ld = 2048; src = P.w_glu;
        c0 = (n0 >> 6) * 32; c1 = 1024 + c0;
        dst = (u16*)(ws + O_WGLU) + (size_t)n0 * 1024;
    } else if (job < 2720) {
        const int lt = job - 2464; n0 = (lt >> 3) * 64; kt = lt & 7; K = 1024; ld = 2048; src = P.w_ssm_out; c0 = n0; c1 = c0 + 32;
        dst = (u16*)(ws + O_WSSMO) + (size_t)n0 * 1024;
    } else if (job < 2976) {
        const int lt = job - 2720; n0 = (lt >> 3) * 64; kt = lt & 7; K = 1024; ld = 2048; src = P.w_attn_out; c0 = n0; c1 = c0 + 32;
        dst = (u16*)(ws + O_WATTO) + (size_t)n0 * 1024;
    } else if (job < 3488) {
        const int lt = job - 2976; n0 = (lt >> 4) * 64; kt = lt & 15; K = 2048; ld = 2048; src = P.w_o; c0 = n0; c1 = c0 + 32;
        dst = (u16*)(ws + O_WO) + (size_t)n0 * 2048;
    } else if (job < 4000) {
        const int lt = job - 3488; n0 = (lt >> 4) * 64; kt = lt & 15; K = 2048; ld = 2048; src = P.w_ple_gate; c0 = n0; c1 = c0 + 32; ksc = P.g_ple;
        dst = (u16*)(ws + O_WPG) + (size_t)n0 * 2048;
    } else {
        const int lt = job - 4000; n0 = (lt >> 1) * 64; kt = lt & 1; K = 256; ld = 2048; src = P.w_ple; c0 = n0; c1 = c0 + 32;
        dst = (u16*)(ws + O_WPLE) + (size_t)n0 * 256;
    }
    WcJob j; j.src = src; j.ksc = ksc; j.dst = dst; j.ld = ld; j.c0 = c0; j.c1 = c1; j.nvalid = nvalid; j.K = K; j.k0 = kt * 128;
    return j;
}
DEV void wconv_load(const WcJob& j, float4 (&v)[8]) {
    const int tid = threadIdx.x;
    const int c = (tid & 15) * 4;
    const int sc = (c < 32) ? (j.c0 + c) : (j.c1 + c - 32);
#pragma unroll
    for (int it = 0; it < 8; ++it) {
        const int kr = it * 16 + (tid >> 4);
        v[it] = make_float4(0.f, 0.f, 0.f, 0.f);
        if (c < j.nvalid) v[it] = *(const float4*)(j.src + (size_t)(j.k0 + kr) * j.ld + sc);
    }
}
DEV void wconv_finish(const WcJob& j, const float4 (&v)[8], u16* tile) {
    const int tid = threadIdx.x;
    const int c = (tid & 15) * 4;
#pragma unroll
    for (int it = 0; it < 8; ++it) {
        const int kr = it * 16 + (tid >> 4);
        const float f = j.ksc ? j.ksc[j.k0 + kr] : 1.f;
        uint2 o; o.x = pack2(v[it].x * f, v[it].y * f); o.y = pack2(v[it].z * f, v[it].w * f);
        *(uint2*)(tile + kr * 68 + c) = o;
    }
    __syncthreads();
    const int n = tid & 63, kq = (tid >> 6) * 32;
    u16* dp = j.dst + (size_t)n * j.K + j.k0 + kq;
#pragma unroll
    for (int h = 0; h < 4; ++h) {
        uint32_t w[4];
#pragma unroll
        for (int e = 0; e < 4; ++e) w[e] = (uint32_t)tile[(kq + h * 8 + 2 * e) * 68 + n] | ((uint32_t)tile[(kq + h * 8 + 2 * e + 1) * 68 + n] << 16);
        *(uint4*)(dp + h * 8) = make_uint4(w[0], w[1], w[2], w[3]);
    }
    __syncthreads();
}
DEV void wconv_run(const Params& P, int first, int end, int stride, u16* tile) {
    if (first >= end) return;
    float4 va[8], vb[8];
    wconv_load(wconv_decode(P, first), va);
    for (int job = first; job < end; job += 2 * stride) {
        if (job + stride < end) wconv_load(wconv_decode(P, job + stride), vb);
        wconv_finish(wconv_decode(P, job), va, tile);
        if (job + stride < end) {
            if (job + 2 * stride < end) wconv_load(wconv_decode(P, job + 2 * stride), va);
            wconv_finish(wconv_decode(P, job + stride), vb, tile);
        }
    }
}

DEV void phaseA(const Params& P, unsigned char* smem) {
    const int tid = threadIdx.x, lane = tid & 63, wid = tid >> 6;
    const int nb = gridDim.x;
    unsigned char* ws = P.ws;
    wconv_run(P, blockIdx.x, 2208, nb, (u16*)smem);
    for (int job = blockIdx.x; job < 2048; job += nb) {
        const int row = job * 4 + wid;
        const float4* xr = (const float4*)(P.x + (size_t)row * 2048);
        const float4* gr = (const float4*)P.g_mix;
        float4 v[8];
        float ss = 0.f;
#pragma unroll
        for (int i = 0; i < 8; ++i) { v[i] = xr[lane + 64 * i]; ss += v[i].x * v[i].x + v[i].y * v[i].y + v[i].z * v[i].z + v[i].w * v[i].w; }
        ss = wave_sum(ss);
        const float rinv = rsqrtf(ss * (1.f / 2048.f) + 1e-6f);
        u16* hr = (u16*)(ws + O_H) + (size_t)row * 2048;
#pragma unroll
        for (int i = 0; i < 8; ++i) {
            const float4 g = gr[lane + 64 * i];
            uint2 o; o.x = pack2(v[i].x * rinv * g.x, v[i].y * rinv * g.y); o.y = pack2(v[i].z * rinv * g.z, v[i].w * rinv * g.w);
            *(uint2*)(hr + (lane + 64 * i) * 4) = o;
        }
    }
    for (int job = blockIdx.x; job < 16; job += nb) {
        const int gn = job * 256 + tid, g = gn >> 6, n = gn & 63;
        const float dt = expf(P.log_dt[g]);
        const float ar = P.a_re[gn], ai = P.a_im[gn];
        const float mag = expf(dt * ar);
        const float abr = mag * cosf(dt * ai), abi = mag * sinf(dt * ai);
        const float den = ar * ar + ai * ai, nr = abr - 1.f;
        const float fr = (nr * ar + abi * ai) / den, fi = (abi * ar - nr * ai) / den;
        ((float2*)(ws + O_ABAR))[gn] = make_float2(abr, abi);
        float pr = abr, pi = abi;
#pragma unroll
        for (int s = 0; s < 8; ++s) { const float t = pr * pr - pi * pi; pi = 2.f * pr * pi; pr = t; }
        ((float2*)(ws + O_ABART))[gn] = make_float2(pr, pi);
        const int rc = (n >> 5) * 64 + (n & 31), ic = rc + 32;
        u16* bbt = (u16*)(ws + O_BBT) + (size_t)g * 128 * 16;
        u16* cct = (u16*)(ws + O_CCT) + (size_t)g * 32 * 128;
        for (int c = 0; c < 16; ++c) {
            const float br = P.b_re[gn * 16 + c], bi = P.b_im[gn * 16 + c];
            bbt[rc * 16 + c] = f2bf(fr * br - fi * bi);
            bbt[ic * 16 + c] = f2bf(fr * bi + fi * br);
            cct[c * 128 + rc] = f2bf(P.c_re[(g * 16 + c) * 64 + n]);
            cct[c * 128 + ic] = f2bf(-P.c_im[(g * 16 + c) * 64 + n]);
            cct[(16 + c) * 128 + rc] = 0;
            cct[(16 + c) * 128 + ic] = 0;
        }
    }
}

DEV void phaseB(const Params& P, unsigned char* smem) {
    ACC_IDS
    unsigned char* ws = P.ws;
    for (int job = blockIdx.x; job < 4160 + 1856 + 1024; job += gridDim.x) {
        if (job >= 4160) {
            if (job < 4160 + 1856) { const WcJob wj = wconv_decode(P, job - 4160 + 2208); float4 vv[8]; wconv_load(wj, vv); wconv_finish(wj, vv, (u16*)smem); }
            else {
                const size_t e0 = (size_t)(job - 4160 - 1856) * 2048 + threadIdx.x * 8;
                const float4 a = *(const float4*)(P.p + e0), b = *(const float4*)(P.p + e0 + 4);
                uint4 o; o.x = pack2(a.x, a.y); o.y = pack2(a.z, a.w); o.z = pack2(b.x, b.y); o.w = pack2(b.z, b.w);
                *(uint4*)((u16*)(ws + O_PBF) + e0) = o;
            }
            continue;
        }
        const int mt = job & 63, nt = job >> 6;
        f32x16 acc[2][2];
        ZERO_ACC(acc);
        gemm_mainloop((const u16*)(ws + O_H) + (size_t)mt * 128 * 2048, 2048, (const u16*)(ws + O_WIN) + (size_t)nt * 128 * 2048, 2048, 2048, smem, acc);
        const int m0 = mt * 128;
        float* st = (float*)smem;
        u16* dst = nullptr; int ld = 0, cofs = 0, act = 0;
        if (nt < 8) { dst = (u16*)(ws + O_U); ld = 1024; cofs = nt * 128; }
        else if (nt < 16) { dst = (u16*)(ws + O_ZS); ld = 1024; cofs = (nt - 8) * 128; act = 1; }
        else if (nt < 20) { dst = (u16*)(ws + O_CQ); ld = 512; cofs = (nt - 16) * 128; }
        else if (nt < 22) { dst = (u16*)(ws + O_K); ld = 256; cofs = (nt - 20) * 128; }
        else if (nt < 24) { dst = (u16*)(ws + O_V); ld = 256; cofs = (nt - 22) * 128; }
        else if (nt < 32) { dst = (u16*)(ws + O_ZA); ld = 1024; cofs = (nt - 24) * 128; act = 1; }
        else if (nt < 48) { dst = (u16*)(ws + O_GS); ld = 2048; cofs = (nt - 32) * 128; act = 2; }
        else if (nt < 64) { dst = (u16*)(ws + O_GA); ld = 2048; cofs = (nt - 48) * 128; act = 2; }
#pragma unroll 1
        for (int mi = 0; mi < 2; ++mi) {
            stage_half(acc, mi, st);
            FOR_CHUNKS(st) {
                CHUNK_LOAD(st)
                const int row = m0 + SR_TO_ROW(sr_, mi);
                if (nt < 64) {
                    if (act == 1) { _Pragma("unroll") for (int e = 0; e < 8; ++e) v_[e] = siluf_(v_[e]); }
                    else if (act == 2) { _Pragma("unroll") for (int e = 0; e < 8; ++e) v_[e] = sigmoidf_(v_[e]); }
                    *(uint4*)(dst + (size_t)row * ld + cofs + col0_) = pack8(v_);
                    if (nt >= 16 && nt < 20) {
                        float ss = 0.f;
                        _Pragma("unroll") for (int e = 0; e < 8; ++e) ss += v_[e] * v_[e];
                        ss += __shfl_xor(ss, 1); ss += __shfl_xor(ss, 2); ss += __shfl_xor(ss, 4); ss += __shfl_xor(ss, 8);
                        if ((threadIdx.x & 15) == 0) ((float*)(ws + O_SSQC))[(size_t)row * 4 + (nt - 16)] = ss;
                    }
                } else if (col0_ < 64) {
                    float* kr = (float*)(ws + O_KIDXRAW) + (size_t)row * 64 + col0_;
                    *(float4*)kr = make_float4(v_[0], v_[1], v_[2], v_[3]);
                    *(float4*)(kr + 4) = make_float4(v_[4], v_[5], v_[6], v_[7]);
                } else if (col0_ < 80) {
                    float* wr = (float*)(ws + O_WIDX) + (size_t)row * 16 + (col0_ - 64);
                    const float sc = 1.f / 32.f;
                    *(float4*)wr = make_float4(v_[0] * sc, v_[1] * sc, v_[2] * sc, v_[3] * sc);
                    *(float4*)(wr + 4) = make_float4(v_[4] * sc, v_[5] * sc, v_[6] * sc, v_[7] * sc);
                }
            }
            __syncthreads();
        }
    }
}

template <bool PASS2>
DEV void s5_unit(const Params& P, int g, int c, unsigned char* wsm) {
    const int lane = threadIdx.x & 63;
    const int l31 = lane & 31, hl = lane >> 5;
    unsigned char* ws = P.ws;
    float* bu = (float*)wsm;
    const u16* U = (const u16*)(ws + O_U);
    const u16* bbt = (const u16*)(ws + O_BBT) + (size_t)g * 128 * 16;
    bf16x8 bb0 = *(const bf16x8*)(bbt + (0 * 32 + l31) * 16 + 8 * hl);
    bf16x8 bb1 = *(const bf16x8*)(bbt + (1 * 32 + l31) * 16 + 8 * hl);
    bf16x8 bb2 = *(const bf16x8*)(bbt + (2 * 32 + l31) * 16 + 8 * hl);
    bf16x8 bb3 = *(const bf16x8*)(bbt + (3 * 32 + l31) * 16 + 8 * hl);
    const float2 ab = ((const float2*)(ws + O_ABAR))[g * 64 + lane];
    const int rc = (lane >> 5) * 64 + l31, ic = rc + 32;
    bf16x8 cfr[8];
    bf16x8 dfr = {0, 0, 0, 0, 0, 0, 0, 0};
    if (PASS2) {
        const short dbf = (short)f2bf(P.d_skip[g * 16 + (l31 & 15)]);
#pragma unroll
        for (int j = 0; j < 8; ++j) dfr[j] = (l31 == 8 * hl + j) ? dbf : (short)0;
    }
    if (PASS2) {
        const u16* cct = (const u16*)(ws + O_CCT) + (size_t)g * 32 * 128;
#pragma unroll
        for (int ks = 0; ks < 8; ++ks) cfr[ks] = *(const bf16x8*)(cct + l31 * 128 + ks * 16 + 8 * hl);
    }
    float hr = 0.f, hi = 0.f;
    if (PASS2) {
        const float2 abT = ((const float2*)(ws + O_ABART))[g * 64 + lane];
        const float2* E = (const float2*)(ws + O_ENDST);
        for (int cc = 0; cc < c; ++cc) {
            const float2 e = E[((size_t)cc * 64 + g) * 64 + lane];
            const float t = abT.x * hr - abT.y * hi + e.x;
            hi = abT.x * hi + abT.y * hr + e.y;
            hr = t;
        }
    }
    bf16x8 ua_next = __builtin_nontemporal_load((const bf16x8*)(U + (size_t)(c * 256 + l31) * 1024 + g * 16 + 8 * hl));
    for (int st = 0; st < 8; ++st) {
        const int t0 = c * 256 + st * 32;
        const bf16x8 ua = ua_next;
        if (st + 1 < 8) ua_next = __builtin_nontemporal_load((const bf16x8*)(U + (size_t)(t0 + 32 + l31) * 1024 + g * 16 + 8 * hl));
        f32x16 z;
#pragma unroll
        for (int r = 0; r < 16; ++r) z[r] = 0.f;
        f32x16 c0 = __builtin_amdgcn_mfma_f32_32x32x16_bf16(ua, bb0, z, 0, 0, 0);
        f32x16 c1 = __builtin_amdgcn_mfma_f32_32x32x16_bf16(ua, bb1, z, 0, 0, 0);
        f32x16 c2 = __builtin_amdgcn_mfma_f32_32x32x16_bf16(ua, bb2, z, 0, 0, 0);
        f32x16 c3 = __builtin_amdgcn_mfma_f32_32x32x16_bf16(ua, bb3, z, 0, 0, 0);
        LDS_FENCE();
#pragma unroll
        for (int r = 0; r < 16; ++r) {
            const int row = (r & 3) + 8 * (r >> 2) + 4 * hl;
            bu[row * 132 + l31] = c0[r];
            bu[row * 132 + 32 + l31] = c1[r];
            bu[row * 132 + 64 + l31] = c2[r];
            bu[row * 132 + 96 + l31] = c3[r];
        }
        LDS_FENCE();
#pragma unroll
        for (int hb = 0; hb < 2; ++hb) {
            float vr[16], vi[16];
#pragma unroll
            for (int r = 0; r < 16; ++r) { vr[r] = bu[(hb * 16 + r) * 132 + rc]; vi[r] = bu[(hb * 16 + r) * 132 + ic]; }
            LDS_FENCE();
#pragma unroll
            for (int r = 0; r < 16; ++r) {
                const float t = ab.x * hr - ab.y * hi + vr[r];
                hi = ab.x * hi + ab.y * hr + vi[r];
                hr = t;
                if (PASS2) {
                    u16* hrow = (u16*)(bu + (hb * 16 + r) * 132);
                    hrow[rc] = f2bf(hr);
                    hrow[ic] = f2bf(hi);
                }
            }
        }
        if (PASS2) {
            LDS_FENCE();
            f32x16 y;
#pragma unroll
            for (int r = 0; r < 16; ++r) y[r] = 0.f;
#pragma unroll
            for (int ks = 0; ks < 8; ++ks) {
                const bf16x8 ha = *(const bf16x8*)((const unsigned char*)bu + l31 * 528 + (ks * 16 + 8 * hl) * 2);
                y = __builtin_amdgcn_mfma_f32_32x32x16_bf16(ha, cfr[ks], y, 0, 0, 0);
            }
            y = __builtin_amdgcn_mfma_f32_32x32x16_bf16(ua, dfr, y, 0, 0, 0);
            if (l31 < 16) {
#pragma unroll
                for (int r = 0; r < 16; ++r) {
                    const int tl = (r & 3) + 8 * (r >> 2) + 4 * hl;
                    ((u16*)((unsigned char*)bu + tl * 528 + 256))[l31] = f2bf(geluf_(y[r]));
                }
            }
            LDS_FENCE();
            if (lane < 32) {
                const uint4 y0 = *(const uint4*)((const unsigned char*)bu + lane * 528 + 256), y1 = *(const uint4*)((const unsigned char*)bu + lane * 528 + 272);
                u16* yp = (u16*)(ws + O_YACT) + (size_t)(t0 + lane) * 1024 + g * 16;
                typedef unsigned u32x4n __attribute__((ext_vector_type(4))); const u32x4n n0_ = {y0.x, y0.y, y0.z, y0.w}, n1_ = {y1.x, y1.y, y1.z, y1.w};
                __builtin_nontemporal_store(n0_, (u32x4n*)yp); __builtin_nontemporal_store(n1_, (u32x4n*)(yp + 8));
            }
            LDS_FENCE();
        }
    }
    if (!PASS2) ((float2*)(ws + O_ENDST))[((size_t)c * 64 + g) * 64 + lane] = make_float2(hr, hi);
}

DEV void phaseC(const Params& P, unsigned char* smem) {
    ACC_IDS
    const int tid = threadIdx.x, wid = tid >> 6;
    unsigned char* ws = P.ws;
    float* rinv_s = (float*)(smem + 65536);
    for (int job = blockIdx.x; job < 1024 + 32 + 512; job += gridDim.x) {
        if (job < 1024) {
            const int mt = job & 63, nt = job >> 6, m0 = mt * 128;
            const u16* cq = (const u16*)(ws + O_CQ);
            if (tid < 128) {
                const float4 q = *(const float4*)((const float*)(ws + O_SSQC) + (size_t)(m0 + tid) * 4);
                rinv_s[tid] = rsqrtf((q.x + q.y + q.z + q.w) * (1.f / 512.f) + 1e-6f);
            }
            f32x16 acc[2][2];
            ZERO_ACC(acc);
            gemm_mainloop(cq + (size_t)m0 * 512, 512, (const u16*)(ws + O_WUQ) + (size_t)nt * 128 * 512, 512, 512, smem, acc);
            u16* dst = (u16*)(ws + (nt < 8 ? O_Q : O_QIDX));
            const int cofs = (nt & 7) * 128;
            float* st = (float*)smem;
#pragma unroll 1
            for (int mi = 0; mi < 2; ++mi) {
                stage_half(acc, mi, st);
                FOR_CHUNKS(st) {
                    CHUNK_LOAD(st)
                    const int rl = SR_TO_ROW(sr_, mi);
                    const float ri = rinv_s[rl];
                    _Pragma("unroll") for (int e = 0; e < 8; ++e) v_[e] *= ri;
                    *(uint4*)(dst + (size_t)(m0 + rl) * 1024 + cofs + col0_) = pack8(v_);
                }
                __syncthreads();
            }
        } else if (job < 1056) {
            const int row = (job - 1024) * 256 + tid;
            const float4* kr = (const float4*)((const float*)(ws + O_KIDXRAW) + (size_t)row * 64);
            float4 v[16];
            float ss = 0.f;
#pragma unroll
            for (int i = 0; i < 16; ++i) { v[i] = kr[i]; ss += v[i].x * v[i].x + v[i].y * v[i].y + v[i].z * v[i].z + v[i].w * v[i].w; }
            const float rinv = rsqrtf(ss * (1.f / 64.f) + 1e-6f);
            const float4* gk = (const float4*)P.g_kidx;
            u16* o = (u16*)(ws + O_KIDX) + (size_t)(row >> 5) * 2048 + (row & 31) * 8;
#pragma unroll
            for (int i = 0; i < 16; ++i) {
                const float4 g = gk[i];
                uint2 w; w.x = pack2(v[i].x * rinv * g.x, v[i].y * rinv * g.y); w.y = pack2(v[i].z * rinv * g.z, v[i].w * rinv * g.w);
                *(uint2*)(o + (i >> 1) * 256 + (i & 1) * 4) = w;
            }
        } else {
            const int unit = (job - 1056) * 4 + wid;
            s5_unit<false>(P, unit & 63, unit >> 6, smem + wid * 16896);
        }
    }
}

constexpr int RW = 8208;
constexpr uint32_t PADKEY = 0x0EB60D35u;
DEV int bucket_of(float sc) { return (int)fminf(fmaxf((sc + 4.f) * 32.f, 0.f), 255.f); }
DEV float key2f(uint32_t k) { return __uint_as_float((k & 0x80000000u) ? (k ^ 0x80000000u) : ~k); }
DEV int bucket_of_key(uint32_t k) { return (k == PADKEY) ? -1 : bucket_of(key2f(k)); }
DEV uint32_t first_key_with_bucket(int bt) {
    const int lane = threadIdx.x & 63;
    uint32_t lo = PADKEY, hi = 0xFF800000u;
    while (hi - lo > 1u) {
        const uint32_t span = hi - lo, step = (span + 63u) >> 6;
        const unsigned long long off = (unsigned long long)step * (unsigned)(lane + 1);
        const uint32_t cand = (off >= span) ? hi : lo + (uint32_t)off;
        const bool pr = bucket_of_key(cand) >= bt;
        const int f = __ffsll((long long)__ballot(pr)) - 1;
        const uint32_t nhi = (uint32_t)__shfl((int)cand, f);
        const unsigned long long offl = (unsigned long long)step * (unsigned)f;
        const uint32_t nlo = (f == 0) ? lo : ((offl >= span) ? hi : lo + (uint32_t)offl);
        hi = nhi; lo = nlo;
    }
    return hi;
}
DEV uint32_t f2key(float f) { const uint32_t u = __float_as_uint(f); return u ^ ((uint32_t)((int32_t)u >> 31) | 0x80000000u); }

DEV void idx_score_tile(const bf16x8 (&a)[4], const bf16x8 (&b)[4], const float (&w)[16], float& p0, float& p1) {
    f32x16 acc;
#pragma unroll
    for (int r = 0; r < 16; ++r) acc[r] = 0.f;
#pragma unroll
    for (int ks = 0; ks < 4; ++ks) acc = __builtin_amdgcn_mfma_f32_32x32x16_bf16(a[ks], b[ks], acc, 0, 0, 0);
    p0 = 0.f; p1 = 0.f;
#pragma unroll
    for (int r = 0; r < 8; ++r) { p0 += w[r] * fmaxf(acc[r], 0.f); p1 += w[r + 8] * fmaxf(acc[r + 8], 0.f); }
    typedef unsigned u32x2_ __attribute__((ext_vector_type(2)));
    const u32x2_ sw = __builtin_amdgcn_permlane32_swap(__float_as_uint(p0), __float_as_uint(p1), false, false);
    p0 = __uint_as_float(sw[0]) + __uint_as_float(sw[1]);
    p1 = p0;
}

DEV void attn_job(const Params& P, int j, int rot, unsigned char* smem) {
    const int tid = threadIdx.x, lane = tid & 63, wid = tid >> 6;
    const int l31 = lane & 31, hl = lane >> 5;
    unsigned char* ws = P.ws;
    uint32_t* rows = (uint32_t*)smem;
    uint32_t* hist_all = (uint32_t*)(smem + 2 * RW * 4);
    const int tl0 = 2 * j, tl1 = 2 * j + 1, th0 = 8190 - 2 * j, th1 = 8191 - 2 * j;
    uint32_t* rowL0 = rows;
    uint32_t* rowH1 = rows + ((tl0 + 4) & ~3);
    uint32_t* rowL1 = rows + RW;
    uint32_t* rowH0 = rows + RW + ((tl1 + 4) & ~3);
    const int role = wid ^ ((rot & 1) << 1);
    hist_all[tid] = 0u; hist_all[tid + 256] = 0u; hist_all[tid + 512] = 0u; hist_all[tid + 768] = 0u;
    __syncthreads();
    const u16* QI = (const u16*)(ws + O_QIDX);
    const u16* KI = (const u16*)(ws + O_KIDX);
    const float* WI = (const float*)(ws + O_WIDX);
    for (int rep1 = 0; rep1 < (PROBE_SEC == 1 ? 2 : 1); ++rep1) {
        bf16x8 aL[4], aH[4];
        float wL[16], wH[16];
        {
            const int qi = l31 >> 4, head = l31 & 15;
            const u16* pl = QI + (size_t)(qi ? tl1 : tl0) * 1024 + head * 64 + 8 * hl;
            const u16* ph = QI + (size_t)(qi ? th1 : th0) * 1024 + head * 64 + 8 * hl;
#pragma unroll
            for (int ks = 0; ks < 4; ++ks) { aL[ks] = __builtin_nontemporal_load((const bf16x8*)(pl + ks * 16)); aH[ks] = __builtin_nontemporal_load((const bf16x8*)(ph + ks * 16)); }
#pragma unroll
            for (int r = 0; r < 16; ++r) {
                const int q = r >> 3, hd = (r & 3) + 8 * ((r >> 2) & 1) + 4 * hl;
                wL[r] = WI[(size_t)(q ? tl1 : tl0) * 16 + hd];
                wH[r] = WI[(size_t)(q ? th1 : th0) * 16 + hd];
            }
        }
        const int nkt = (th1 >> 5) + 1;
        bf16x8 bq[3][4];
#define KLOAD(u, ktv) { const int kc_ = min((ktv), nkt - 1); const u16* kp_ = KI + (size_t)kc_ * 2048 + hl * 256 + l31 * 8; \
            _Pragma("unroll") for (int ks = 0; ks < 4; ++ks) bq[u][ks] = *(const bf16x8*)(kp_ + ks * 512); }
        uint32_t* const rowHs = hl ? rowH1 : rowH0; const int tHs = hl ? th1 : th0; uint32_t* const hHs = hist_all + (2 + hl) * 256;
        uint32_t* const rowLs = hl ? rowL1 : rowL0; const int tLs = hl ? tl1 : tl0; uint32_t* const hLs = hist_all + hl * 256;
#define ROWPUT(rowp, hp, tq, pv) if (key < (((tq) + 4) & ~3)) { const bool ok_ = key <= (tq); rowp[key] = ok_ ? f2key(pv) : PADKEY; if (ok_) atomicAdd(&hp[bucket_of(pv)], 1u); }
#define KTILE(u, ktv) if ((ktv) < nkt) { const int key = (ktv) * 32 + l31; float p0, p1; \
            idx_score_tile(aH, bq[u], wH, p0, p1); \
            ROWPUT(rowHs, hHs, tHs, p0) \
            if ((ktv) * 32 <= tl1) { idx_score_tile(aL, bq[u], wL, p0, p1); ROWPUT(rowLs, hLs, tLs, p0) } }
        KLOAD(0, wid) KLOAD(1, wid + 4) KLOAD(2, wid + 8)
        for (int kt = wid; kt < nkt; kt += 12) {
            KTILE(0, kt) KLOAD(0, kt + 12)
            KTILE(1, kt + 4) KLOAD(1, kt + 16)
            KTILE(2, kt + 8) KLOAD(2, kt + 20)
        }
#undef KLOAD
#undef KTILE
#undef ROWPUT
    }
    __syncthreads();
    uint32_t* row; int t;
    if (role == 0) { row = rowL0; t = tl0; } else if (role == 1) { row = rowL1; t = tl1; } else if (role == 2) { row = rowH0; t = th0; } else { row = rowH1; t = th1; }
    const int n = t + 1;
    uint32_t* hrow = hist_all + role * 256;
    u16* idxl = (u16*)hrow;
    u16* cand = idxl + 256;
    int nsel;
    for (int rep2 = 0; rep2 < (PROBE_SEC == 2 ? 2 : 1); ++rep2)
    if (n <= 256) {
        nsel = n;
        LDS_FENCE();
        for (int i = lane; i < 256; i += 64) idxl[i] = (u16)((i < n) ? i : 0);
    } else {
        nsel = 256;
        int b0; uint32_t kkb, cntb;
        {
            const uint32_t c0 = hrow[255 - 4 * lane], c1 = hrow[254 - 4 * lane], c2 = hrow[253 - 4 * lane], c3 = hrow[252 - 4 * lane];
            const uint32_t sm = c0 + c1 + c2 + c3;
            uint32_t incl = sm;
#pragma unroll
            for (int d = 1; d < 64; d <<= 1) { const uint32_t v = __shfl_up(incl, d); if (lane >= d) incl += v; }
            uint32_t e = incl - sm;
            const bool hit = (e < 256u) && (256u <= incl);
            const int srcl = __ffsll((long long)__ballot(hit)) - 1;
            int bin; uint32_t nk, cb;
            if (e + c0 >= 256u) { bin = 255 - 4 * lane; nk = 256u - e; cb = c0; }
            else { e += c0; if (e + c1 >= 256u) { bin = 254 - 4 * lane; nk = 256u - e; cb = c1; }
            else { e += c1; if (e + c2 >= 256u) { bin = 253 - 4 * lane; nk = 256u - e; cb = c2; }
            else { e += c2; bin = 252 - 4 * lane; nk = 256u - e; cb = c3; } } }
            b0 = __shfl(bin, srcl); kkb = __shfl(nk, srcl); cntb = __shfl(cb, srcl);
        }
        LDS_FENCE();
        if (cntb <= 256u) {
            const int n4 = (n + 3) & ~3;
            const int ngt = 256 - (int)kkb;
            const uint32_t khi = (b0 >= 255) ? 0xFFFFFFFFu : first_key_with_bucket(b0 + 1);
            const uint32_t klo = (b0 <= 0) ? (PADKEY + 1u) : first_key_with_bucket(b0);
            uint32_t cg = 0, ce = 0;
            for (int i4 = lane * 4; i4 < n4; i4 += 256) {
                const uint4 k4 = *(const uint4*)(row + i4);
                cg += (k4.x >= khi) + (k4.y >= khi) + (k4.z >= khi) + (k4.w >= khi);
                ce += (k4.x >= klo) + (k4.y >= klo) + (k4.z >= klo) + (k4.w >= klo);
            }
            ce -= cg;
            uint32_t ig = cg, ie = ce;
#pragma unroll
            for (int d = 1; d < 64; d <<= 1) {
                const uint32_t vg = __shfl_up(ig, d), ve = __shfl_up(ie, d);
                if (lane >= d) { ig += vg; ie += ve; }
            }
            uint32_t bg = ig - cg, be = ie - ce;
            for (int i4 = lane * 4; i4 < n4; i4 += 256) {
                const uint4 k4 = *(const uint4*)(row + i4);
                const uint32_t kv[4] = {k4.x, k4.y, k4.z, k4.w};
#pragma unroll
                for (int e = 0; e < 4; ++e) {
                    if (kv[e] >= khi) { idxl[bg] = (u16)(i4 + e); ++bg; }
                    else if (kv[e] >= klo) { cand[be] = (u16)(i4 + e); ++be; }
                }
            }
            LDS_FENCE();
            uint32_t ck[4]; int ci[4];
#pragma unroll
            for (int c = 0; c < 4; ++c) { const int q = lane + 64 * c; ci[c] = (q < (int)cntb) ? (int)cand[q] : 0; }
#pragma unroll
            for (int c = 0; c < 4; ++c) ck[c] = row[ci[c]];
            LDS_FENCE();
#pragma unroll
            for (int c = 0; c < 4; ++c) { const int q = lane + 64 * c; if (q < (int)cntb) row[q] = ck[c]; }
            LDS_FENCE();
            uint32_t rk[4] = {0u, 0u, 0u, 0u};
            for (int jq = 0; jq < (int)cntb; ++jq) {
                const uint32_t kj = row[jq];
#pragma unroll
                for (int c = 0; c < 4; ++c) rk[c] += ((kj > ck[c]) || (kj == ck[c] && jq < lane + 64 * c)) ? 1u : 0u;
            }
#pragma unroll
            for (int c = 0; c < 4; ++c) { const int q = lane + 64 * c; if (q < (int)cntb && rk[c] < kkb) idxl[ngt + rk[c]] = (u16)ci[c]; }
        } else {
        uint32_t prefix = 0, kk = 256;
        for (int pass = 0; pass < 4; ++pass) {
            const int shift = 24 - 8 * pass;
            hrow[lane] = 0; hrow[lane + 64] = 0; hrow[lane + 128] = 0; hrow[lane + 192] = 0;
            LDS_FENCE();
            const int n4 = (n + 3) & ~3;
            if (pass == 0) {
                for (int i4 = lane * 4; i4 < n4; i4 += 256) {
                    const uint4 k4 = *(const uint4*)(row + i4);
                    atomicAdd(&hrow[k4.x >> 24], 1u); atomicAdd(&hrow[k4.y >> 24], 1u); atomicAdd(&hrow[k4.z >> 24], 1u); atomicAdd(&hrow[k4.w >> 24], 1u);
                }
            } else {
                const int sh8 = shift + 8;
                for (int i4 = lane * 4; i4 < n4; i4 += 256) {
                    const uint4 k4 = *(const uint4*)(row + i4);
                    if ((k4.x >> sh8) == prefix) atomicAdd(&hrow[(k4.x >> shift) & 255u], 1u);
                    if ((k4.y >> sh8) == prefix) atomicAdd(&hrow[(k4.y >> shift) & 255u], 1u);
                    if ((k4.z >> sh8) == prefix) atomicAdd(&hrow[(k4.z >> shift) & 255u], 1u);
                    if ((k4.w >> sh8) == prefix) atomicAdd(&hrow[(k4.w >> shift) & 255u], 1u);
                }
            }
            LDS_FENCE();
            const uint32_t c0 = hrow[255 - 4 * lane], c1 = hrow[254 - 4 * lane], c2 = hrow[253 - 4 * lane], c3 = hrow[252 - 4 * lane];
            const uint32_t s = c0 + c1 + c2 + c3;
            uint32_t incl = s;
#pragma unroll
            for (int d = 1; d < 64; d <<= 1) { const uint32_t v = __shfl_up(incl, d); if (lane >= d) incl += v; }
            uint32_t e = incl - s;
            const bool hit = (e < kk) && (kk <= incl);
            const unsigned long long bm = __ballot(hit);
            const int srcl = __ffsll((long long)bm) - 1;
            int bin; uint32_t nk;
            if (e + c0 >= kk) { bin = 255 - 4 * lane; nk = kk - e; }
            else { e += c0; if (e + c1 >= kk) { bin = 254 - 4 * lane; nk = kk - e; }
            else { e += c1; if (e + c2 >= kk) { bin = 253 - 4 * lane; nk = kk - e; }
            else { e += c2; bin = 252 - 4 * lane; nk = kk - e; } } }
            bin = __shfl(bin, srcl);
            nk = __shfl(nk, srcl);
            prefix = (prefix << 8) | (uint32_t)bin;
            kk = nk;
            LDS_FENCE();
        }
        const uint32_t T = prefix;
        const int ngt = 256 - (int)kk;
        const int n4 = (n + 3) & ~3;
        uint32_t cg = 0, ce = 0;
        for (int i4 = lane * 4; i4 < n4; i4 += 256) {
            const uint4 k4 = *(const uint4*)(row + i4);
            cg += (k4.x > T) + (k4.y > T) + (k4.z > T) + (k4.w > T);
            ce += (k4.x == T) + (k4.y == T) + (k4.z == T) + (k4.w == T);
        }
        uint32_t ig = cg, ie = ce;
#pragma unroll
        for (int d = 1; d < 64; d <<= 1) {
            const uint32_t vg = __shfl_up(ig, d), ve = __shfl_up(ie, d);
            if (lane >= d) { ig += vg; ie += ve; }
        }
        uint32_t bg = ig - cg, be = ie - ce;
        for (int i4 = lane * 4; i4 < n4; i4 += 256) {
            const uint4 k4 = *(const uint4*)(row + i4);
            const uint32_t kv[4] = {k4.x, k4.y, k4.z, k4.w};
#pragma unroll
            for (int e = 0; e < 4; ++e) {
                if (kv[e] > T) { idxl[bg] = (u16)(i4 + e); ++bg; }
                else if (kv[e] == T) { if (be < kk) idxl[ngt + be] = (u16)(i4 + e); ++be; }
            }
        }
        }
    }
    __syncthreads();
    float* lg = (float*)(smem + ((role == 0 || role == 3) ? 0 : RW * 4) + ((role >= 2) ? (RW * 2) : 0));
    const u16* Qp = (const u16*)(ws + O_Q) + (size_t)t * 1024;
    const u16* Kb = (const u16*)(ws + O_K);
    const u16* Vb = (const u16*)(ws + O_V);
    const int l15 = lane & 15, q4 = lane >> 4;
    const float scale = 0.08838834764831845f;
    unsigned char* scr = (unsigned char*)lg;
    for (int rep3 = 0; rep3 < (PROBE_SEC == 3 ? 2 : 1); ++rep3) {
    {
        unsigned char* ktile = scr + 8192;
        unsigned kwofs[8], krd[2][4];
#pragma unroll
        for (int i = 0; i < 8; ++i) { const unsigned row = q4 + 4 * i, ch = l15; kwofs[i] = 256u * row + 16u * (ch ^ (((row & 3) << 2) | ((row >> 2) & 3))); }
#pragma unroll
        for (int rb = 0; rb < 2; ++rb)
#pragma unroll
            for (int sx = 0; sx < 4; ++sx) { const unsigned row = l15 + 16 * rb, ch = 4 * sx + q4; krd[rb][sx] = 256u * row + 16u * (ch ^ (((row & 3) << 2) | ((row >> 2) & 3))); }
        uint4 kr0, kr1, kr2, kr3, kr4, kr5, kr6, kr7;
#define KLD1(i, dst) { const int key = idxl[ck_ * 32 + q4 + 4 * (i)]; dst = *(const uint4*)(Kb + (size_t)key * 256 + g_ * 128 + l15 * 8); }
#define KGLOAD(it_) { const int g_ = (it_) >> 3, ck_ = (it_) & 7; KLD1(0, kr0) KLD1(1, kr1) KLD1(2, kr2) KLD1(3, kr3) KLD1(4, kr4) KLD1(5, kr5) KLD1(6, kr6) KLD1(7, kr7) }
        KGLOAD(0)
#pragma unroll 1
        for (int g = 0; g < 2; ++g) {
            bf16x8 qa[4];
#pragma unroll
            for (int ks = 0; ks < 4; ++ks) {
                bf16x8 z = {0, 0, 0, 0, 0, 0, 0, 0};
                qa[ks] = z;
                if (l15 < 4) qa[ks] = __builtin_nontemporal_load((const bf16x8*)(Qp + (g * 4 + l15) * 128 + ks * 32 + 8 * q4));
            }
#pragma unroll 1
            for (int ck = 0; ck < 8; ++ck) {
                const int it = g * 8 + ck;
                *(uint4*)(ktile + kwofs[0]) = kr0; *(uint4*)(ktile + kwofs[1]) = kr1; *(uint4*)(ktile + kwofs[2]) = kr2; *(uint4*)(ktile + kwofs[3]) = kr3;
                *(uint4*)(ktile + kwofs[4]) = kr4; *(uint4*)(ktile + kwofs[5]) = kr5; *(uint4*)(ktile + kwofs[6]) = kr6; *(uint4*)(ktile + kwofs[7]) = kr7;
                if (it + 1 < 16) KGLOAD(it + 1)
                LDS_FENCE();
#pragma unroll
                for (int rb = 0; rb < 2; ++rb) {
                    f32x4 acc = {0.f, 0.f, 0.f, 0.f};
#pragma unroll
                    for (int sx = 0; sx < 4; ++sx) {
                        const bf16x8 kb = *(const bf16x8*)(ktile + krd[rb][sx]);
                        acc = __builtin_amdgcn_mfma_f32_16x16x32_bf16(qa[sx], kb, acc, 0, 0, 0);
                    }
                    if (lane < 16) {
                        const int kidx = ck * 32 + rb * 16 + lane;
                        const bool ok = kidx < nsel;
#pragma unroll
                        for (int r = 0; r < 4; ++r) lg[(g * 4 + r) * 256 + kidx] = ok ? acc[r] * scale : -INFINITY;
                    }
                }
                LDS_FENCE();
            }
        }
#undef KGLOAD
#undef KLD1
    }
    LDS_FENCE();
    {
        uint2 pk[8];
#pragma unroll
        for (int hh = 0; hh < 8; ++hh) {
            const float4 x = *(const float4*)(lg + hh * 256 + 4 * lane);
            float m = wave_max_fast(fmaxf(fmaxf(x.x, x.y), fmaxf(x.z, x.w)));
            const float e0 = __expf(x.x - m), e1 = __expf(x.y - m), e2 = __expf(x.z - m), e3 = __expf(x.w - m);
            const float inv = 1.f / wave_sum_fast(e0 + e1 + e2 + e3);
            pk[hh].x = pack2(e0 * inv, e1 * inv);
            pk[hh].y = pack2(e2 * inv, e3 * inv);
        }
        LDS_FENCE();
#pragma unroll
        for (int hh = 0; hh < 8; ++hh) *(uint2*)(scr + hh * 512 + lane * 8) = pk[hh];
    }
    }
    LDS_FENCE();
    for (int rep4 = 0; rep4 < (PROBE_SEC == 4 ? 2 : 1); ++rep4) {
        unsigned char* vt = scr + 8192;
        const int q = l15 >> 2, p = l15 & 3;
        unsigned tra[8][2];
#pragma unroll
        for (int c = 0; c < 8; ++c)
#pragma unroll
            for (int tt = 0; tt < 2; ++tt) {
                const unsigned row = 8 * q4 + 4 * tt + q, ch = 2 * c + (p >> 1);
                tra[c][tt] = 256u * row + 16u * (ch ^ (((row & 3) << 2) | ((row >> 2) & 3))) + 8 * (p & 1);
            }
        unsigned wofs[8];
#pragma unroll
        for (int i = 0; i < 8; ++i) {
            const unsigned row = q4 + 4 * i, ch = l15;
            wofs[i] = 256u * row + 16u * (ch ^ (((row & 3) << 2) | ((row >> 2) & 3)));
        }
        uint4 vr0, vr1, vr2, vr3, vr4, vr5, vr6, vr7;
#define VLD1(i, dst) { const int key = idxl[ck_ * 32 + q4 + 4 * (i)]; dst = *(const uint4*)(Vb + (size_t)key * 256 + g_ * 128 + l15 * 8); }
#define VLOAD(it_) { const int g_ = (it_) >> 3, ck_ = (it_) & 7; VLD1(0, vr0) VLD1(1, vr1) VLD1(2, vr2) VLD1(3, vr3) VLD1(4, vr4) VLD1(5, vr5) VLD1(6, vr6) VLD1(7, vr7) }
        VLOAD(0)
        const u16* za = (const u16*)(ws + O_ZA) + (size_t)t * 1024;
        u16* ya = (u16*)(ws + O_YATT) + (size_t)t * 1024;
#pragma unroll 1
        for (int g = 0; g < 2; ++g) {
            f32x4 oacc[8];
#pragma unroll
            for (int c = 0; c < 8; ++c) { f32x4 z = {0.f, 0.f, 0.f, 0.f}; oacc[c] = z; }
#pragma unroll 1
            for (int ck = 0; ck < 8; ++ck) {
                const int it = g * 8 + ck;
                *(uint4*)(vt + wofs[0]) = vr0; *(uint4*)(vt + wofs[1]) = vr1; *(uint4*)(vt + wofs[2]) = vr2; *(uint4*)(vt + wofs[3]) = vr3;
                *(uint4*)(vt + wofs[4]) = vr4; *(uint4*)(vt + wofs[5]) = vr5; *(uint4*)(vt + wofs[6]) = vr6; *(uint4*)(vt + wofs[7]) = vr7;
                if (it + 1 < 16) VLOAD(it + 1)
                LDS_FENCE();
                const bf16x8 pa = *(const bf16x8*)(scr + (g * 4 + l15) * 512 + (ck * 32 + 8 * q4) * 2);
#pragma unroll
                for (int c = 0; c < 8; ++c) {
                    typedef short s16x4 __attribute__((ext_vector_type(4)));
                    const s16x4 lo = __builtin_amdgcn_ds_read_tr16_b64_v4i16((__attribute__((address_space(3))) s16x4*)(vt + tra[c][0]));
                    const s16x4 hi = __builtin_amdgcn_ds_read_tr16_b64_v4i16((__attribute__((address_space(3))) s16x4*)(vt + tra[c][1]));
                    const bf16x8 vb = {lo[0], lo[1], lo[2], lo[3], hi[0], hi[1], hi[2], hi[3]};
                    oacc[c] = __builtin_amdgcn_mfma_f32_16x16x32_bf16(pa, vb, oacc[c], 0, 0, 0);
                }
                LDS_FENCE();
            }
            if (lane < 16) {
#pragma unroll
                for (int c = 0; c < 8; ++c)
#pragma unroll
                    for (int r = 0; r < 4; ++r) {
                        const int cb = (g * 4 + r) * 128 + c * 16 + lane;
                        __builtin_nontemporal_store(f2bf(oacc[c][r] * bf2f(__builtin_nontemporal_load(za + cb))), ya + cb);
                    }
            }
        }
#undef VLOAD
#undef VLD1
    }
    __syncthreads();
}

DEV void phaseD(const Params& P, unsigned char* smem) {
    const int wid = threadIdx.x >> 6;
    const int G = gridDim.x;
    const bool s5_last = (blockIdx.x >> 3) & 1;
    if (!s5_last) {
        for (int job = blockIdx.x; job < 512; job += G) {
            const int unit = job * 4 + wid;
            for (int rep5 = 0; rep5 < (PROBE_SEC == 5 ? 2 : 1); ++rep5) s5_unit<true>(P, unit & 63, unit >> 6, smem + wid * 16896);
            __syncthreads();
        }
    }
    for (int aj = blockIdx.x; aj < 2048; aj += G) attn_job(P, aj, aj / G, smem);
    if (s5_last) {
        for (int job = blockIdx.x; job < 512; job += G) {
            const int unit = job * 4 + wid;
            s5_unit<true>(P, unit & 63, unit >> 6, smem + wid * 16896);
            __syncthreads();
        }
    }
}

DEV void phaseE(const Params& P, unsigned char* smem) {
    ACC_IDS
    unsigned char* ws = P.ws;
    for (int job = blockIdx.x; job < 1024; job += gridDim.x) {
        const int mt = job & 63, nt = job >> 6, m0 = mt * 128;
        f32x16 acc[2][2];
        ZERO_ACC(acc);
        gemm_mainloop((const u16*)(ws + O_YACT) + (size_t)m0 * 1024, 1024, (const u16*)(ws + O_WGLU) + (size_t)nt * 128 * 1024, 1024, 1024, smem, acc);
        const u16* zs = (const u16*)(ws + O_ZS);
        u16* ys = (u16*)(ws + O_U);
        float* st = (float*)smem;
        uint4 zpre[2][2];
#pragma unroll
        for (int mi = 0; mi < 2; ++mi)
#pragma unroll
            for (int i = 0; i < 2; ++i) {
                const int cid = threadIdx.x + 256 * i, sr = cid >> 3, ac = cid & 7;
                zpre[mi][i] = ld_nt16(zs + (size_t)(m0 + SR_TO_ROW(sr, mi)) * 1024 + nt * 64 + (ac >> 2) * 32 + (ac & 3) * 8);
            }
#pragma unroll
        for (int mi = 0; mi < 2; ++mi) {
            stage_half(acc, mi, st);
#pragma unroll
            for (int i = 0; i < 2; ++i) {
                const int cid = threadIdx.x + 256 * i;
                const int sr = cid >> 3, ac = cid & 7;
                const int tcol = (ac >> 2) * 64 + (ac & 3) * 8;
                const int row = m0 + SR_TO_ROW(sr, mi);
                const int ocol = nt * 64 + (ac >> 2) * 32 + (ac & 3) * 8;
                const float4 a0 = *(const float4*)(st + sr * 132 + tcol), a1 = *(const float4*)(st + sr * 132 + tcol + 4);
                const float4 b0 = *(const float4*)(st + sr * 132 + tcol + 32), b1 = *(const float4*)(st + sr * 132 + tcol + 36);
                float z[8];
                unpack8(zpre[mi][i], z);
                float o[8];
                o[0] = a0.x * sigmoidf_(b0.x) * z[0]; o[1] = a0.y * sigmoidf_(b0.y) * z[1]; o[2] = a0.z * sigmoidf_(b0.z) * z[2]; o[3] = a0.w * sigmoidf_(b0.w) * z[3];
                o[4] = a1.x * sigmoidf_(b1.x) * z[4]; o[5] = a1.y * sigmoidf_(b1.y) * z[5]; o[6] = a1.z * sigmoidf_(b1.z) * z[6]; o[7] = a1.w * sigmoidf_(b1.w) * z[7];
                *(uint4*)(ys + (size_t)row * 1024 + ocol) = pack8(o);
            }
            __syncthreads();
        }
    }
}

DEV void phaseF(const Params& P, unsigned char* smem) {
    ACC_IDS
    unsigned char* ws = P.ws;
    const int ntile = (1024 - (int)blockIdx.x + (int)gridDim.x - 1) / (int)gridDim.x;
    uint4 part[2][4];
    for (int q = 0; q < 2 * ntile; ++q) {
        const int job = blockIdx.x + (q >> 1) * gridDim.x, pass = q & 1;
        const int mt = job & 63, nt = job >> 6, m0 = mt * 128, n0 = nt * 128;
        f32x16 acc[2][2];
        ZERO_ACC(acc);
        const u16* A = (const u16*)(ws + (pass ? O_YATT : O_U)) + (size_t)m0 * 1024;
        const u16* B = (const u16*)(ws + (pass ? O_WATTO : O_WSSMO)) + (size_t)n0 * 1024;
        gemm_mainloop(A, 1024, B, 1024, 1024, smem, acc);
        const u16* gt = (const u16*)(ws + (pass ? O_GA : O_GS));
        u16* mg = (u16*)(ws + O_MERGED);
        float* st = (float*)smem;
        uint4 gpre[2][4];
#pragma unroll
        for (int mi = 0; mi < 2; ++mi)
#pragma unroll
            for (int i_ = 0; i_ < 4; ++i_) {
                const int cid_ = threadIdx.x + 256 * i_, sr_ = cid_ >> 4, col0_ = (cid_ & 15) * 8;
                gpre[mi][i_] = ld_nt16(gt + (size_t)(m0 + SR_TO_ROW(sr_, mi)) * 2048 + n0 + col0_);
            }
#pragma unroll
        for (int mi = 0; mi < 2; ++mi) {
            stage_half(acc, mi, st);
#pragma unroll
            for (int i_ = 0; i_ < 4; ++i_) {
                CHUNK_LOAD(st)
                const size_t o = (size_t)(m0 + SR_TO_ROW(sr_, mi)) * 2048 + n0 + col0_;
                float g[8];
                unpack8(gpre[mi][i_], g);
                _Pragma("unroll") for (int e = 0; e < 8; ++e) v_[e] *= g[e];
                if (pass) {
                    float pvv[8];
                    unpack8(part[mi][i_], pvv);
                    _Pragma("unroll") for (int e = 0; e < 8; ++e) v_[e] += pvv[e];
                    *(uint4*)(mg + o) = pack8(v_);
                } else {
                    part[mi][i_] = pack8(v_);
                }
            }
            __syncthreads();
        }
    }
}

DEV void phaseG(const Params& P, unsigned char* smem) {
    ACC_IDS
    unsigned char* ws = P.ws;
    for (int job = blockIdx.x; job < 1024; job += gridDim.x) {
        const int mt = job & 63, nt = job >> 6, m0 = mt * 128, n0 = nt * 128;
        f32x16 acc[2][2];
        ZERO_ACC(acc);
        gemm_mainloop((const u16*)(ws + O_MERGED) + (size_t)m0 * 2048, 2048, (const u16*)(ws + O_WO) + (size_t)n0 * 2048, 2048, 2048, smem, acc);
        u16* xb = (u16*)(ws + O_X1B);
        float* ssq = (float*)(ws + O_SSQ1);
        float* st = (float*)smem;
#pragma unroll 1
        for (int mi = 0; mi < 2; ++mi) {
            stage_half(acc, mi, st);
            FOR_CHUNKS(st) {
                CHUNK_LOAD(st)
                const int row = m0 + SR_TO_ROW(sr_, mi);
                const size_t o = (size_t)row * 2048 + n0 + col0_;
                const float4 x0 = *(const float4*)(P.x + o), x1 = *(const float4*)(P.x + o + 4);
                v_[0] += x0.x; v_[1] += x0.y; v_[2] += x0.z; v_[3] += x0.w; v_[4] += x1.x; v_[5] += x1.y; v_[6] += x1.z; v_[7] += x1.w;
                *(float4*)(P.out + o) = make_float4(v_[0], v_[1], v_[2], v_[3]);
                *(float4*)(P.out + o + 4) = make_float4(v_[4], v_[5], v_[6], v_[7]);
                *(uint4*)(xb + o) = pack8(v_);
                float ss = 0.f;
                _Pragma("unroll") for (int e = 0; e < 8; ++e) ss += v_[e] * v_[e];
                ss += __shfl_xor(ss, 1); ss += __shfl_xor(ss, 2); ss += __shfl_xor(ss, 4); ss += __shfl_xor(ss, 8);
                if ((threadIdx.x & 15) == 0) ssq[(size_t)row * 16 + nt] = ss;
            }
            __syncthreads();
        }
    }
}

DEV void phaseH(const Params& P, unsigned char* smem) {
    ACC_IDS
    const int tid = threadIdx.x;
    unsigned char* ws = P.ws;
    float* rinv_s = (float*)(smem + 65536);
    for (int job = blockIdx.x; job < 2048; job += gridDim.x) {
        const int jj = job & 1023;
        const int mt = jj & 63, nt = jj >> 6, m0 = mt * 128, n0 = nt * 128;
        f32x16 acc[2][2];
        ZERO_ACC(acc);
        if (job < 1024) {
            {
                const int row = tid >> 1, half = tid & 1;
                const float4* sp = (const float4*)((const float*)(ws + O_SSQ1) + (size_t)(m0 + row) * 16 + half * 8);
                float ss = 0.f;
#pragma unroll
                for (int i = 0; i < 2; ++i) { const float4 q = sp[i]; ss += q.x + q.y + q.z + q.w; }
                ss += __shfl_xor(ss, 1);
                if (half == 0) rinv_s[row] = rsqrtf(ss * (1.f / 2048.f) + 1e-6f);
            }
            gemm_mainloop((const u16*)(ws + O_X1B) + (size_t)m0 * 2048, 2048, (const u16*)(ws + O_WPG) + (size_t)n0 * 2048, 2048, 2048, smem, acc);
            u16* gt = (u16*)(ws + O_GS);
            float* st = (float*)smem;
#pragma unroll 1
            for (int mi = 0; mi < 2; ++mi) {
                stage_half(acc, mi, st);
                FOR_CHUNKS(st) {
                    CHUNK_LOAD(st)
                    const int rl = SR_TO_ROW(sr_, mi);
                    const float ri = rinv_s[rl];
                    _Pragma("unroll") for (int e = 0; e < 8; ++e) v_[e] = sigmoidf_(v_[e] * ri);
                    *(uint4*)(gt + (size_t)(m0 + rl) * 2048 + n0 + col0_) = pack8(v_);
                }
                __syncthreads();
            }
        } else {
            gemm_mainloop((const u16*)(ws + O_PBF) + (size_t)m0 * 256, 256, (const u16*)(ws + O_WPLE) + (size_t)n0 * 256, 256, 256, smem, acc);
            u16* er = (u16*)(ws + O_GA);
            float* ssq = (float*)(ws + O_SSQE);
            float* st = (float*)smem;
#pragma unroll 1
            for (int mi = 0; mi < 2; ++mi) {
                stage_half(acc, mi, st);
                FOR_CHUNKS(st) {
                    CHUNK_LOAD(st)
                    const int row = m0 + SR_TO_ROW(sr_, mi);
                    *(uint4*)(er + (size_t)row * 2048 + n0 + col0_) = pack8(v_);
                    float ss = 0.f;
                    _Pragma("unroll") for (int e = 0; e < 8; ++e) ss += v_[e] * v_[e];
                    ss += __shfl_xor(ss, 1); ss += __shfl_xor(ss, 2); ss += __shfl_xor(ss, 4); ss += __shfl_xor(ss, 8);
                    if ((threadIdx.x & 15) == 0) ssq[(size_t)row * 16 + nt] = ss;
                }
                __syncthreads();
            }
        }
    }
}

DEV void phaseI(const Params& P, unsigned char* smem) {
    const int tid = threadIdx.x, lane = tid & 63, wid = tid >> 6;
    unsigned char* ws = P.ws;
    for (int job = blockIdx.x; job < 2048; job += gridDim.x) {
        const int row = job * 4 + wid;
        float sse = (lane < 16) ? ((const float*)(ws + O_SSQE))[(size_t)row * 16 + lane] : 0.f;
        sse = wave_sum(sse);
        const float rinv_e = rsqrtf(sse * (1.f / 2048.f) + 1e-6f);
        float4* xo = (float4*)(P.out + (size_t)row * 2048);
        const uint2* gt = (const uint2*)((const u16*)(ws + O_GS) + (size_t)row * 2048);
        const uint2* er = (const uint2*)((const u16*)(ws + O_GA) + (size_t)row * 2048);
        const float4* gp = (const float4*)P.g_ple_post;
        const float4* gf = (const float4*)P.g_final;
        float4 v[8];
        float ss = 0.f;
#pragma unroll
        for (int i = 0; i < 8; ++i) {
            const int c = lane + 64 * i;
            const float4 x1 = xo[c];
            const uint2 g2 = gt[c], e2 = er[c];
            const float4 gg = gp[c];
            float4 o;
            o.x = x1.x + __uint_as_float(g2.x << 16) * (__uint_as_float(e2.x << 16) * rinv_e * gg.x);
            o.y = x1.y + __uint_as_float(g2.x & 0xFFFF0000u) * (__uint_as_float(e2.x & 0xFFFF0000u) * rinv_e * gg.y);
            o.z = x1.z + __uint_as_float(g2.y << 16) * (__uint_as_float(e2.y << 16) * rinv_e * gg.z);
            o.w = x1.w + __uint_as_float(g2.y & 0xFFFF0000u) * (__uint_as_float(e2.y & 0xFFFF0000u) * rinv_e * gg.w);
            v[i] = o;
            ss += o.x * o.x + o.y * o.y + o.z * o.z + o.w * o.w;
        }
        ss = wave_sum(ss);
        const float rinv = rsqrtf(ss * (1.f / 2048.f) + 1e-6f);
#pragma unroll
        for (int i = 0; i < 8; ++i) {
            const int c = lane + 64 * i;
            const float4 g = gf[c];
            xo[c] = make_float4(v[i].x * rinv * g.x, v[i].y * rinv * g.y, v[i].z * rinv * g.z, v[i].w * rinv * g.w);
        }
    }
}

#define XB_TMO      128
#define XB_XCNT(j)  (256  + 64 * (j))
#define XB_XSUB(j)  (1280 + 64 * (j))
#define XB_XGEN(j)  (2304 + 64 * (j))
#define XB_TOP      3328
#define XB_TOPGEN   3392
#define XCD_BAR_WORDS 3456
#define XB_SPIN_CAP (1u << 18)
#define LAS __attribute__((address_space(3)))

__device__ __forceinline__ unsigned xb_ld(unsigned* p)              { return __hip_atomic_load(p, __ATOMIC_RELAXED, __HIP_MEMORY_SCOPE_AGENT); }
__device__ __forceinline__ unsigned xb_add(unsigned* p, unsigned v) { return __hip_atomic_fetch_add(p, v, __ATOMIC_RELAXED, __HIP_MEMORY_SCOPE_AGENT); }
__device__ __forceinline__ unsigned xb_xcc_id() { return (unsigned)__builtin_amdgcn_s_getreg((3 << 11) | 20) & 0xFu; }
#define XB_SPIN(cond, bar) do { unsigned _sp = 0; while (cond) { __builtin_amdgcn_s_sleep(1); \
    if ((++_sp & 255u) == 0u) { if (xb_ld(&(bar)[XB_TMO])) break; if (_sp > XB_SPIN_CAP) { atomicAdd(&(bar)[XB_TMO], 1u); break; } } } } while (0)

struct XcdBarrier {
    unsigned* bar; unsigned x;
    volatile LAS unsigned* st;
};

__device__ __forceinline__ XcdBarrier xcd_barrier_post(unsigned* bar, volatile LAS unsigned* st) {
    XcdBarrier b; b.bar = bar; b.x = xb_xcc_id(); b.st = st;
    if (threadIdx.x == 0) (void)xb_add(&bar[XB_XCNT(b.x)], 1u);
    return b;
}
__device__ __forceinline__ void xcd_barrier_complete(unsigned* bar, unsigned x, unsigned& nloc, unsigned& nx) {
    const unsigned G = gridDim.x * gridDim.y * gridDim.z;
    unsigned sum, cnt, mine, sp = 0u;
    for (;;) {
        sum = 0u; cnt = 0u; mine = 0u;
#pragma unroll
        for (unsigned j = 0; j < 16; ++j) { const unsigned c = xb_ld(&bar[XB_XCNT(j)]); sum += c; cnt += (c > 0u) ? 1u : 0u; mine = (j == x) ? c : mine; }
        if (sum == G) break;
        __builtin_amdgcn_s_sleep(1);
        if ((++sp & 255u) == 0u) { if (xb_ld(&bar[XB_TMO])) break; if (sp > XB_SPIN_CAP) { atomicAdd(&bar[XB_TMO], 1u); break; } }
    }
    nloc = mine > 0u ? mine : 1u; nx = cnt > 0u ? cnt : 1u;
}

__device__ __forceinline__ void xcd_barrier(const XcdBarrier& b) {
    asm volatile("s_waitcnt vmcnt(0)" ::: "memory");
    __syncthreads();
    if (threadIdx.x == 0) {
        unsigned* bar = b.bar;
        __builtin_amdgcn_s_waitcnt(0);
        unsigned nloc = b.st[0], nx = b.st[1];
        if (nloc == 0u) { xcd_barrier_complete(bar, b.x, nloc, nx); b.st[0] = nloc; b.st[1] = nx; }
        const unsigned old = xb_add(&bar[XB_XSUB(b.x)], 1u);
        const unsigned gen = old / nloc;
        if (old + 1u == (gen + 1u) * nloc) {
            __builtin_amdgcn_fence(__ATOMIC_RELEASE, "agent");
            asm volatile("s_waitcnt vmcnt(0)" ::: "memory");
            const unsigned og = xb_add(&bar[XB_TOP], 1u);
            const unsigned tg = og / nx;
            if (og + 1u == (tg + 1u) * nx) xb_add(&bar[XB_TOPGEN], 1u);
            else XB_SPIN(xb_ld(&bar[XB_TOPGEN]) == tg, bar);
            __builtin_amdgcn_fence(__ATOMIC_ACQUIRE, "agent");
            xb_add(&bar[XB_XGEN(b.x)], 1u);
            asm volatile("s_waitcnt vmcnt(0)" ::: "memory");
        } else {
            XB_SPIN(xb_ld(&bar[XB_XGEN(b.x)]) == gen, bar);
            __builtin_amdgcn_fence(__ATOMIC_ACQUIRE, "agent");
            asm volatile("s_waitcnt vmcnt(0)" ::: "memory");
        }
    }
    __syncthreads();
}


__global__ void __launch_bounds__(256, 2) mega(Params P) {
    extern __shared__ __align__(16) unsigned char smem[];
    cg::grid_group grid = cg::this_grid();
    const int lo = P.ph_lo, hi = P.ph_hi;
    volatile LAS unsigned* xst = (volatile LAS unsigned*)(smem + LDS_BYTES - 16);
    if (threadIdx.x == 0) { xst[0] = 0u; xst[1] = 0u; }
    __syncthreads();
    const XcdBarrier xb = xcd_barrier_post((unsigned*)(P.ws + O_BAR), xst);
    if (lo < 0) grid.sync();
    if (lo <= 0 && 0 < hi) phaseA(P, smem);
#if PROBE_DUP == 0
    xcd_barrier(xb); phaseA(P, smem);
#endif
    if (lo < 1 && 1 < hi) xcd_barrier(xb);
    if (lo <= 1 && 1 < hi) phaseB(P, smem);
#if PROBE_DUP == 1
    xcd_barrier(xb); phaseB(P, smem);
#endif
    if (lo < 2 && 2 < hi) xcd_barrier(xb);
    if (lo <= 2 && 2 < hi) phaseC(P, smem);
#if PROBE_DUP == 2
    xcd_barrier(xb); phaseC(P, smem);
#endif
    if (lo < 3 && 3 < hi) xcd_barrier(xb);
    if (lo <= 3 && 3 < hi) phaseD(P, smem);
#if PROBE_DUP == 3
    xcd_barrier(xb); phaseD(P, smem);
#endif
    if (lo < 4 && 4 < hi) xcd_barrier(xb);
    if (lo <= 4 && 4 < hi) phaseE(P, smem);
#if PROBE_DUP == 4
    xcd_barrier(xb); phaseE(P, smem);
#endif
    if (lo < 5 && 5 < hi) xcd_barrier(xb);
    if (lo <= 5 && 5 < hi) phaseF(P, smem);
#if PROBE_DUP == 5
    xcd_barrier(xb); phaseF(P, smem);
#endif
    if (lo < 6 && 6 < hi) xcd_barrier(xb);
    if (lo <= 6 && 6 < hi) phaseG(P, smem);
#if PROBE_DUP == 6
    xcd_barrier(xb); phaseG(P, smem);
#endif
    if (lo < 7 && 7 < hi) xcd_barrier(xb);
    if (lo <= 7 && 7 < hi) phaseH(P, smem);
#if PROBE_DUP == 7
    xcd_barrier(xb); phaseH(P, smem);
#endif
    if (lo < 8 && 8 < hi) xcd_barrier(xb);
    if (lo <= 8 && 8 < hi) phaseI(P, smem);
}

extern "C" void kernel_launch(void* const* d_in, const int* in_sizes, int n_in, void* d_out, int out_size,
                              void* d_ws, size_t ws_size, hipStream_t stream) {
    static int grid_blocks = 0;
    if (!grid_blocks) {
        if (n_in != 25 || ws_size < WS_END) { fprintf(stderr, "kernel_launch: unexpected n_in %d / ws %zu (need %zu)\n", n_in, ws_size, (size_t)WS_END); grid_blocks = -1; return; }
        int dev = 0, cus = 0, per_cu = 0;
        hipGetDevice(&dev);
        hipDeviceGetAttribute(&cus, hipDeviceAttributeMultiprocessorCount, dev);
        hipFuncSetAttribute((const void*)mega, hipFuncAttributeMaxDynamicSharedMemorySize, LDS_BYTES);
        hipOccupancyMaxActiveBlocksPerMultiprocessor(&per_cu, (const void*)mega, 256, LDS_BYTES);
        if (per_cu < 1) per_cu = 1;
        if (per_cu > 2) per_cu = 2;
        grid_blocks = cus * per_cu;
    }
    if (grid_blocks < 0) return;
    Params p{};
    const float** f = (const float**)&p;
    for (int i = 0; i < 25; ++i) f[i] = (const float*)d_in[i];
    p.out = (float*)d_out;
    p.ws = (unsigned char*)d_ws;
    (void)hipMemsetAsync((unsigned char*)d_ws + O_BAR, 0, XCD_BAR_WORDS * sizeof(unsigned), stream);
#if N_LAUNCH_MODE == 1
    p.ph_lo = 0; p.ph_hi = NPHASE;
    void* args[] = {&p};
    hipError_t e = hipLaunchCooperativeKernel((const void*)mega, dim3(grid_blocks), dim3(256), args, LDS_BYTES, stream);
    if (e != hipSuccess) fprintf(stderr, "cooperative launch failed: %s (grid %d)\n", hipGetErrorString(e), grid_blocks);
#else
    for (int ph = 0; ph < NPHASE; ++ph) {
        p.ph_lo = ph; p.ph_hi = ph + 1;
        hipLaunchKernelGGL(mega, dim3(grid_blocks), dim3(256), LDS_BYTES, stream, p);
    }
#endif
}
```

```cpp
#include <hip/hip_runtime.h>
#include <hip/hip_cooperative_groups.h>
#include <stdint.h>
#include <stdio.h>
namespace cg = cooperative_groups;

#ifndef PROBE_DUP
#define PROBE_DUP -1
#endif
#ifndef PROBE_SEC
#define PROBE_SEC 0
#endif
#ifndef N_LAUNCH_MODE
#define N_LAUNCH_MODE 1
#endif

typedef unsigned short u16;
typedef short bf16x8 __attribute__((ext_vector_type(8)));
typedef float f32x16 __attribute__((ext_vector_type(16)));
typedef float f32x4 __attribute__((ext_vector_type(4)));

#define DEV __device__ __forceinline__
#define LDS_FENCE() asm volatile("s_waitcnt lgkmcnt(0)" ::: "memory")

constexpr int NPHASE = 9;
constexpr int LDS_BYTES = 70656;

constexpr size_t O_WIN = 0;
constexpr size_t O_YACT = 0;
constexpr size_t O_YATT = 16777216;
constexpr size_t O_WUQ = 34078720;
constexpr size_t O_WGLU = O_WUQ + 2097152;
constexpr size_t O_WSSMO = O_WGLU + 4194304;
constexpr size_t O_WATTO = O_WSSMO + 4194304;
constexpr size_t O_WO = O_WATTO + 4194304;
constexpr size_t O_WPG = O_WO + 8388608;
constexpr size_t O_WPLE = O_WPG + 8388608;
constexpr size_t O_H = O_WPLE + 1048576;
constexpr size_t O_Q = O_H;
constexpr size_t O_QIDX = O_H + 16777216;
constexpr size_t O_MERGED = O_H;
constexpr size_t O_U = O_H + 33554432;
constexpr size_t O_ZS = O_U + 16777216;
constexpr size_t O_X1B = O_U;
constexpr size_t O_CQ = O_ZS + 16777216;
constexpr size_t O_K = O_CQ + 8388608;
constexpr size_t O_V = O_K + 4194304;
constexpr size_t O_ZA = O_V + 4194304;
constexpr size_t O_GS = O_ZA + 16777216;
constexpr size_t O_GA = O_GS + 33554432;
constexpr size_t O_KIDXRAW = O_GA + 33554432;
constexpr size_t O_KIDX = O_KIDXRAW + 2097152;
constexpr size_t O_WIDX = O_KIDX + 1048576;
constexpr size_t O_PBF = O_WIDX + 524288;
constexpr size_t O_ABAR = O_PBF + 4194304;
constexpr size_t O_ABART = O_ABAR + 32768;
constexpr size_t O_BBT = O_ABART + 32768;
constexpr size_t O_CCT = O_BBT + 262144;
constexpr size_t O_ENDST = O_CCT + 524288;
constexpr size_t O_SSQ1 = O_ENDST + 1048576;
constexpr size_t O_SSQE = O_SSQ1 + 1048576;
constexpr size_t O_SSQC = O_SSQE + 1048576;
constexpr size_t O_BAR = O_SSQC + 131072;
constexpr size_t WS_END = O_BAR + 16384;

struct Params {
    const float *x, *p, *g_mix, *w_in, *g_q, *w_uq, *w_uq_idx, *g_kidx, *a_re, *a_im, *log_dt, *b_re, *b_im,
        *c_re, *c_im, *d_skip, *w_glu, *w_ssm_out, *w_attn_out, *w_o, *g_ple, *w_ple_gate, *w_ple, *g_ple_post, *g_final;
    float* out;
    unsigned char* ws;
    int ph_lo, ph_hi;
};

DEV u16 f2bf(float f) { uint32_t u = __float_as_uint(f); u += 0x7FFFu + ((u >> 16) & 1u); return (u16)(u >> 16); }
DEV float bf2f(u16 h) { return __uint_as_float(((uint32_t)h) << 16); }
DEV uint32_t pack2(float a, float b) { return (uint32_t)f2bf(a) | ((uint32_t)f2bf(b) << 16); }
DEV float sigmoidf_(float x) { return 1.f / (1.f + __expf(-x)); }
DEV float siluf_(float x) { return x / (1.f + __expf(-x)); }
DEV float geluf_(float x) { float u = 0.7978845608028654f * (x + 0.044715f * x * x * x); return x - x / (1.f + __expf(2.f * u)); }
DEV float wave_sum(float v) { for (int d = 32; d >= 1; d >>= 1) v += __shfl_xor(v, d); return v; }
#define DPPF_(v, ctrl) __int_as_float(__builtin_amdgcn_mov_dpp(__float_as_int(v), ctrl, 0xF, 0xF, true))
DEV float wave_max_fast(float v) {
    v = fmaxf(v, DPPF_(v, 0xB1)); v = fmaxf(v, DPPF_(v, 0x4E)); v = fmaxf(v, DPPF_(v, 0x141)); v = fmaxf(v, DPPF_(v, 0x140));
    const float r0 = __int_as_float(__builtin_amdgcn_readlane(__float_as_int(v), 0)), r1 = __int_as_float(__builtin_amdgcn_readlane(__float_as_int(v), 16));
    const float r2 = __int_as_float(__builtin_amdgcn_readlane(__float_as_int(v), 32)), r3 = __int_as_float(__builtin_amdgcn_readlane(__float_as_int(v), 48));
    return fmaxf(fmaxf(r0, r1), fmaxf(r2, r3));
}
DEV float wave_sum_fast(float v) {
    v += DPPF_(v, 0xB1); v += DPPF_(v, 0x4E); v += DPPF_(v, 0x141); v += DPPF_(v, 0x140);
    const float r0 = __int_as_float(__builtin_amdgcn_readlane(__float_as_int(v), 0)), r1 = __int_as_float(__builtin_amdgcn_readlane(__float_as_int(v), 16));
    const float r2 = __int_as_float(__builtin_amdgcn_readlane(__float_as_int(v), 32)), r3 = __int_as_float(__builtin_amdgcn_readlane(__float_as_int(v), 48));
    return (r0 + r1) + (r2 + r3);
}
DEV float wave_max(float v) { for (int d = 32; d >= 1; d >>= 1) v = fmaxf(v, __shfl_xor(v, d)); return v; }

DEV void gemm_mainloop(const u16* __restrict__ A, int lda, const u16* __restrict__ B, int ldb, int K,
                       unsigned char* smem, f32x16 (&acc)[2][2]) {
    const int tid = threadIdx.x, lane = tid & 63, wid = tid >> 6;
    const int wm = wid >> 1, wn = wid & 1;
    const int lrow = tid >> 3, lslot = tid & 7;
    uint4 pa0, pa1, pa2, pa3, pb0, pb1, pb2, pb3;
    uint4 qa0, qa1, qa2, qa3, qb0, qb1, qb2, qb3;
    const u16* Ap = A + (size_t)lrow * lda + lslot * 8;
    const u16* Bp = B + (size_t)lrow * ldb + lslot * 8;
    const size_t a32 = (size_t)32 * lda, b32 = (size_t)32 * ldb;
    const int woff = lrow * 128 + ((lslot ^ ((lrow >> 1) & 7)) << 4);
#define GLOAD(S, k0) { S##a0 = *(const uint4*)(Ap + (k0)); S##a1 = *(const uint4*)(Ap + a32 + (k0)); S##a2 = *(const uint4*)(Ap + 2 * a32 + (k0)); S##a3 = *(const uint4*)(Ap + 3 * a32 + (k0)); \
                       S##b0 = *(const uint4*)(Bp + (k0)); S##b1 = *(const uint4*)(Bp + b32 + (k0)); S##b2 = *(const uint4*)(Bp + 2 * b32 + (k0)); S##b3 = *(const uint4*)(Bp + 3 * b32 + (k0)); }
#define SWRITE(S, buf) { unsigned char* as_ = smem + (buf) * 16384 + woff; unsigned char* bs_ = smem + 32768 + (buf) * 16384 + woff; \
                      *(uint4*)(as_) = S##a0; *(uint4*)(as_ + 4096) = S##a1; *(uint4*)(as_ + 8192) = S##a2; *(uint4*)(as_ + 12288) = S##a3; \
                      *(uint4*)(bs_) = S##b0; *(uint4*)(bs_ + 4096) = S##b1; *(uint4*)(bs_ + 8192) = S##b2; *(uint4*)(bs_ + 12288) = S##b3; }
    const int nk = K >> 6;
    const int rA = wm * 64 + (lane & 31), rB = wn * 64 + (lane & 31);
    const int swA = (rA >> 1) & 7, swB = (rB >> 1) & 7;
    const int h = lane >> 5;
#define FRAG(ks, a0, a1, b0, b1) const int slot##ks = (ks) * 2 + h; \
            const bf16x8 a0 = *(const bf16x8*)(as_ + ((slot##ks ^ swA) << 4)); const bf16x8 a1 = *(const bf16x8*)(as_ + 4096 + ((slot##ks ^ swA) << 4)); \
            const bf16x8 b0 = *(const bf16x8*)(bs_ + ((slot##ks ^ swB) << 4)); const bf16x8 b1 = *(const bf16x8*)(bs_ + 4096 + ((slot##ks ^ swB) << 4));
#define MM(a0, a1, b0, b1) acc[0][0] = __builtin_amdgcn_mfma_f32_32x32x16_bf16(a0, b0, acc[0][0], 0, 0, 0); acc[0][1] = __builtin_amdgcn_mfma_f32_32x32x16_bf16(a0, b1, acc[0][1], 0, 0, 0); \
            acc[1][0] = __builtin_amdgcn_mfma_f32_32x32x16_bf16(a1, b0, acc[1][0], 0, 0, 0); acc[1][1] = __builtin_amdgcn_mfma_f32_32x32x16_bf16(a1, b1, acc[1][1], 0, 0, 0);
#define COMPUTE(cur) { const unsigned char* as_ = smem + (cur) * 16384 + rA * 128; const unsigned char* bs_ = smem + 32768 + (cur) * 16384 + rB * 128; \
        FRAG(0, fa00, fa01, fb00, fb01) FRAG(1, fa10, fa11, fb10, fb11) FRAG(2, fa20, fa21, fb20, fb21) FRAG(3, fa30, fa31, fb30, fb31) \
        MM(fa00, fa01, fb00, fb01) MM(fa10, fa11, fb10, fb11) MM(fa20, fa21, fb20, fb21) MM(fa30, fa31, fb30, fb31) \
        __builtin_amdgcn_sched_group_barrier(0x100, 8, 0); __builtin_amdgcn_sched_group_barrier(0x008, 4, 0); \
        __builtin_amdgcn_sched_group_barrier(0x100, 4, 0); __builtin_amdgcn_sched_group_barrier(0x008, 4, 0); \
        __builtin_amdgcn_sched_group_barrier(0x100, 4, 0); __builtin_amdgcn_sched_group_barrier(0x008, 8, 0); }
    GLOAD(p, 0);
    GLOAD(q, 64);
    SWRITE(p, 0);
    __syncthreads();
    for (int kt = 0; kt < nk; kt += 2) {
        if (kt + 2 < nk) GLOAD(p, (kt + 2) * 64);
        COMPUTE(0);
        SWRITE(q, 1);
        __syncthreads();
        if (kt + 3 < nk) GLOAD(q, (kt + 3) * 64);
        COMPUTE(1);
        if (kt + 2 < nk) SWRITE(p, 0);
        __syncthreads();
    }
#undef GLOAD
#undef SWRITE
#undef COMPUTE
#undef FRAG
#undef MM
}

DEV void stage_half(const f32x16 (&acc)[2][2], int mi, float* st) {
    const int lane = threadIdx.x & 63, wid = threadIdx.x >> 6, wm = wid >> 1, wn = wid & 1;
#pragma unroll
    for (int ni = 0; ni < 2; ++ni)
#pragma unroll
        for (int r = 0; r < 16; ++r)
            st[(wm * 32 + (r & 3) + 8 * (r >> 2) + 4 * (lane >> 5)) * 132 + wn * 64 + ni * 32 + (lane & 31)] = mi ? acc[1][ni][r] : acc[0][ni][r];
    __syncthreads();
}
#define SR_TO_ROW(sr, mi) ((((sr) >> 5) << 6) + (mi) * 32 + ((sr) & 31))
typedef unsigned u32x4nt __attribute__((ext_vector_type(4)));
DEV uint4 ld_nt16(const void* p) { const u32x4nt t = __builtin_nontemporal_load((const u32x4nt*)p); return make_uint4(t[0], t[1], t[2], t[3]); }
DEV uint4 pack8(const float (&v)[8]) { uint4 o; o.x = pack2(v[0], v[1]); o.y = pack2(v[2], v[3]); o.z = pack2(v[4], v[5]); o.w = pack2(v[6], v[7]); return o; }
DEV void unpack8(const uint4 q, float (&v)[8]) {
    v[0] = __uint_as_float(q.x << 16); v[1] = __uint_as_float(q.x & 0xFFFF0000u); v[2] = __uint_as_float(q.y << 16); v[3] = __uint_as_float(q.y & 0xFFFF0000u);
    v[4] = __uint_as_float(q.z << 16); v[5] = __uint_as_float(q.z & 0xFFFF0000u); v[6] = __uint_as_float(q.w << 16); v[7] = __uint_as_float(q.w & 0xFFFF0000u);
}
#define FOR_CHUNKS(st) _Pragma("unroll") for (int i_ = 0; i_ < 4; ++i_)
#define CHUNK_LOAD(st) const int cid_ = threadIdx.x + 256 * i_; const int sr_ = cid_ >> 4, col0_ = (cid_ & 15) * 8; float v_[8]; \
    { const float4 x0_ = *(const float4*)((st) + sr_ * 132 + col0_), x1_ = *(const float4*)((st) + sr_ * 132 + col0_ + 4); \
      v_[0] = x0_.x; v_[1] = x0_.y; v_[2] = x0_.z; v_[3] = x0_.w; v_[4] = x1_.x; v_[5] = x1_.y; v_[6] = x1_.z; v_[7] = x1_.w; }

DEV int cbar_() { asm volatile("" ::: "memory"); return 0; }
#define ZERO_ACC(acc) { _Pragma("unroll") for (int i_ = 0; i_ < 2; ++i_) _Pragma("unroll") for (int j_ = 0; j_ < 2; ++j_) _Pragma("unroll") for (int r_ = 0; r_ < 16; ++r_) acc[i_][j_][r_] = 0.f; }
#define FOR_ACC _Pragma("unroll") for (int mi = 0; mi < 2; ++mi) _Pragma("unroll") for (int ni = 0; ni < 2; ++ni) _Pragma("unroll") for (int r = cbar_(); r < 16; ++r)
#define ACC_ROW (wm_ * 64 + mi * 32 + (r & 3) + 8 * (r >> 2) + 4 * (lane_ >> 5))
#define ACC_COL (wn_ * 64 + ni * 32 + (lane_ & 31))
#define ACC_IDS const int lane_ = threadIdx.x & 63, wm_ = (threadIdx.x >> 6) >> 1, wn_ = (threadIdx.x >> 6) & 1;

struct WcJob { const float* src; const float* ksc; u16* dst; int ld, c0, c1, nvalid, K, k0; };
DEV WcJob wconv_decode(const Params& P, int job) {
    unsigned char* ws = P.ws;
    const float* src; const float* ksc = nullptr; u16* dst; int ld, c0, c1, nvalid = 64, K, kt, n0;
    if (job < 2080) {
        n0 = (job >> 4) * 64; kt = job & 15; K = 2048; src = P.w_in; ld = 8272;
        if (n0 < 4096) c0 = n0; else if (n0 < 8192) c0 = n0 + 80; else { c0 = n0 - 8192 + 4096; nvalid = min(64, max(0, 8272 - n0)); }
        c1 = c0 + 32;
        dst = (u16*)(ws + O_WIN) + (size_t)n0 * 2048;
    } else if (job < 2208) {
        const int lt = job - 2080; n0 = (lt >> 2) * 64; kt = lt & 3; K = 512; ld = 1024; ksc = P.g_q;
        if (n0 < 1024) { src = P.w_uq; c0 = n0; } else { src = P.w_uq_idx; c0 = n0 - 1024; }
        c1 = c0 + 32;
        dst = (u16*)(ws + O_WUQ) + (size_t)n0 * 512;
    } else if (job < 2464) {
        const int lt = job - 2208; n0 = (lt >> 3) * 64; kt = lt & 7; K = 1024; ld = 2048; src = P.w_glu;
        c0 = (n0 >> 6) * 32; c1 = 1024 + c0;
        dst = (u16*)(ws + O_WGLU) + (size_t)n0 * 1024;
    } else if (job < 2720) {
        const int lt = job - 2464; n0 = (lt >> 3) * 64; kt = lt & 7; K = 1024; ld = 2048; src = P.w_ssm_out; c0 = n0; c1 = c0 + 32;
        dst = (u16*)(ws + O_WSSMO) + (size_t)n0 * 1024;
    } else if (job < 2976) {
        const int lt = job - 2720; n0 = (lt >> 3) * 64; kt = lt & 7; K = 1024; ld = 2048; src = P.w_attn_out; c0 = n0; c1 = c0 + 32;
        dst = (u16*)(ws + O_WATTO) + (size_t)n0 * 1024;
    } else if (job < 3488) {
        const int lt = job - 2976; n0 = (lt >> 4) * 64; kt = lt & 15; K = 2048; ld = 2048; src = P.w_o; c0 = n0; c1 = c0 + 32;
        dst = (u16*)(ws + O_WO) + (size_t)n0 * 2048;
    } else if (job < 4000) {
        const int lt = job - 3488; n0 = (lt >> 4) * 64; kt = lt & 15; K = 2048; ld = 2048; src = P.w_ple_gate; c0 = n0; c1 = c0 + 32; ksc = P.g_ple;
        dst = (u16*)(ws + O_WPG) + (size_t)n0 * 2048;
    } else {
        const int lt = job - 4000; n0 = (lt >> 1) * 64; kt = lt & 1; K = 256; ld = 2048; src = P.w_ple; c0 = n0; c1 = c0 + 32;
        dst = (u16*)(ws + O_WPLE) + (size_t)n0 * 256;
    }
    WcJob j; j.src = src; j.ksc = ksc; j.dst = dst; j.ld = ld; j.c0 = c0; j.c1 = c1; j.nvalid = nvalid; j.K = K; j.k0 = kt * 128;
    return j;
}
DEV void wconv_load(const WcJob& j, float4 (&v)[8]) {
    const int tid = threadIdx.x;
    const int c = (tid & 15) * 4;
    const int sc = (c < 32) ? (j.c0 + c) : (j.c1 + c - 32);
#pragma unroll
    for (int it = 0; it < 8; ++it) {
        const int kr = it * 16 + (tid >> 4);
        v[it] = make_float4(0.f, 0.f, 0.f, 0.f);
        if (c < j.nvalid) v[it] = *(const float4*)(j.src + (size_t)(j.k0 + kr) * j.ld + sc);
    }
}
DEV void wconv_finish(const WcJob& j, const float4 (&v)[8], u16* tile) {
    const int tid = threadIdx.x;
    const int c = (tid & 15) * 4;
#pragma unroll
    for (int it = 0; it < 8; ++it) {
        const int kr = it * 16 + (tid >> 4);
        const float f = j.ksc ? j.ksc[j.k0 + kr] : 1.f;
        uint2 o; o.x = pack2(v[it].x * f, v[it].y * f); o.y = pack2(v[it].z * f, v[it].w * f);
        *(uint2*)(tile + kr * 68 + c) = o;
    }
    __syncthreads();
    const int n = tid & 63, kq = (tid >> 6) * 32;
    u16* dp = j.dst + (size_t)n * j.K + j.k0 + kq;
#pragma unroll
    for (int h = 0; h < 4; ++h) {
        uint32_t w[4];
#pragma unroll
        for (int e = 0; e < 4; ++e) w[e] = (uint32_t)tile[(kq + h * 8 + 2 * e) * 68 + n] | ((uint32_t)tile[(kq + h * 8 + 2 * e + 1) * 68 + n] << 16);
        *(uint4*)(dp + h * 8) = make_uint4(w[0], w[1], w[2], w[3]);
    }
    __syncthreads();
}
DEV void wconv_run(const Params& P, int first, int end, int stride, u16* tile) {
    if (first >= end) return;
    float4 va[8], vb[8];
    wconv_load(wconv_decode(P, first), va);
    for (int job = first; job < end; job += 2 * stride) {
        if (job + stride < end) wconv_load(wconv_decode(P, job + stride), vb);
        wconv_finish(wconv_decode(P, job), va, tile);
        if (job + stride < end) {
            if (job + 2 * stride < end) wconv_load(wconv_decode(P, job + 2 * stride), va);
            wconv_finish(wconv_decode(P, job + stride), vb, tile);
        }
    }
}

DEV void phaseA(const Params& P, unsigned char* smem) {
    const int tid = threadIdx.x, lane = tid & 63, wid = tid >> 6;
    const int nb = gridDim.x;
    unsigned char* ws = P.ws;
    wconv_run(P, blockIdx.x, 2208, nb, (u16*)smem);
    for (int job = blockIdx.x; job < 2048; job += nb) {
        const int row = job * 4 + wid;
        const float4* xr = (const float4*)(P.x + (size_t)row * 2048);
        const float4* gr = (const float4*)P.g_mix;
        float4 v[8];
        float ss = 0.f;
#pragma unroll
        for (int i = 0; i < 8; ++i) { typedef float f32x4n_ __attribute__((ext_vector_type(4))); const f32x4n_ t_ = __builtin_nontemporal_load((const f32x4n_*)(xr + lane + 64 * i)); v[i] = make_float4(t_[0], t_[1], t_[2], t_[3]); ss += v[i].x * v[i].x + v[i].y * v[i].y + v[i].z * v[i].z + v[i].w * v[i].w; }
        ss = wave_sum(ss);
        const float rinv = rsqrtf(ss * (1.f / 2048.f) + 1e-6f);
        u16* hr = (u16*)(ws + O_H) + (size_t)row * 2048;
#pragma unroll
        for (int i = 0; i < 8; ++i) {
            const float4 g = gr[lane + 64 * i];
            uint2 o; o.x = pack2(v[i].x * rinv * g.x, v[i].y * rinv * g.y); o.y = pack2(v[i].z * rinv * g.z, v[i].w * rinv * g.w);
            *(uint2*)(hr + (lane + 64 * i) * 4) = o;
        }
    }
    for (int job = blockIdx.x; job < 16; job += nb) {
        const int gn = job * 256 + tid, g = gn >> 6, n = gn & 63;
        const float dt = expf(P.log_dt[g]);
        const float ar = P.a_re[gn], ai = P.a_im[gn];
        const float mag = expf(dt * ar);
        const float abr = mag * cosf(dt * ai), abi = mag * sinf(dt * ai);
        const float den = ar * ar + ai * ai, nr = abr - 1.f;
        const float fr = (nr * ar + abi * ai) / den, fi = (abi * ar - nr * ai) / den;
        ((float2*)(ws + O_ABAR))[gn] = make_float2(abr, abi);
        float pr = abr, pi = abi;
#pragma unroll
        for (int s = 0; s < 8; ++s) { const float t = pr * pr - pi * pi; pi = 2.f * pr * pi; pr = t; }
        ((float2*)(ws + O_ABART))[gn] = make_float2(pr, pi);
        const int rc = (n >> 5) * 64 + (n & 31), ic = rc + 32;
        u16* bbt = (u16*)(ws + O_BBT) + (size_t)g * 128 * 16;
        u16* cct = (u16*)(ws + O_CCT) + (size_t)g * 32 * 128;
        for (int c = 0; c < 16; ++c) {
            const float br = P.b_re[gn * 16 + c], bi = P.b_im[gn * 16 + c];
            bbt[rc * 16 + c] = f2bf(fr * br - fi * bi);
            bbt[ic * 16 + c] = f2bf(fr * bi + fi * br);
            cct[c * 128 + rc] = f2bf(P.c_re[(g * 16 + c) * 64 + n]);
            cct[c * 128 + ic] = f2bf(-P.c_im[(g * 16 + c) * 64 + n]);
            cct[(16 + c) * 128 + rc] = 0;
            cct[(16 + c) * 128 + ic] = 0;
        }
    }
}

DEV void phaseB(const Params& P, unsigned char* smem) {
    ACC_IDS
    unsigned char* ws = P.ws;
    for (int job = blockIdx.x; job < 4160 + 1856 + 1024; job += gridDim.x) {
        if (job >= 4160) {
            if (job < 4160 + 1856) { const WcJob wj = wconv_decode(P, job - 4160 + 2208); float4 vv[8]; wconv_load(wj, vv); wconv_finish(wj, vv, (u16*)smem); }
            else {
                const size_t e0 = (size_t)(job - 4160 - 1856) * 2048 + threadIdx.x * 8;
                const float4 a = *(const float4*)(P.p + e0), b = *(const float4*)(P.p + e0 + 4);
                uint4 o; o.x = pack2(a.x, a.y); o.y = pack2(a.z, a.w); o.z = pack2(b.x, b.y); o.w = pack2(b.z, b.w);
                *(uint4*)((u16*)(ws + O_PBF) + e0) = o;
            }
            continue;
        }
        const int mt = job & 63, nt = job >> 6;
        f32x16 acc[2][2];
        ZERO_ACC(acc);
        gemm_mainloop((const u16*)(ws + O_H) + (size_t)mt * 128 * 2048, 2048, (const u16*)(ws + O_WIN) + (size_t)nt * 128 * 2048, 2048, 2048, smem, acc);
        const int m0 = mt * 128;
        float* st = (float*)smem;
        u16* dst = nullptr; int ld = 0, cofs = 0, act = 0;
        if (nt < 8) { dst = (u16*)(ws + O_U); ld = 1024; cofs = nt * 128; }
        else if (nt < 16) { dst = (u16*)(ws + O_ZS); ld = 1024; cofs = (nt - 8) * 128; act = 1; }
        else if (nt < 20) { dst = (u16*)(ws + O_CQ); ld = 512; cofs = (nt - 16) * 128; }
        else if (nt < 22) { dst = (u16*)(ws + O_K); ld = 256; cofs = (nt - 20) * 128; }
        else if (nt < 24) { dst = (u16*)(ws + O_V); ld = 256; cofs = (nt - 22) * 128; }
        else if (nt < 32) { dst = (u16*)(ws + O_ZA); ld = 1024; cofs = (nt - 24) * 128; act = 1; }
        else if (nt < 48) { dst = (u16*)(ws + O_GS); ld = 2048; cofs = (nt - 32) * 128; act = 2; }
        else if (nt < 64) { dst = (u16*)(ws + O_GA); ld = 2048; cofs = (nt - 48) * 128; act = 2; }
#pragma unroll 1
        for (int mi = 0; mi < 2; ++mi) {
            stage_half(acc, mi, st);
            FOR_CHUNKS(st) {
                CHUNK_LOAD(st)
                const int row = m0 + SR_TO_ROW(sr_, mi);
                if (nt < 64) {
                    if (act == 1) { _Pragma("unroll") for (int e = 0; e < 8; ++e) v_[e] = siluf_(v_[e]); }
                    else if (act == 2) { _Pragma("unroll") for (int e = 0; e < 8; ++e) v_[e] = sigmoidf_(v_[e]); }
                    *(uint4*)(dst + (size_t)row * ld + cofs + col0_) = pack8(v_);
                    if (nt >= 16 && nt < 20) {
                        float ss = 0.f;
                        _Pragma("unroll") for (int e = 0; e < 8; ++e) ss += v_[e] * v_[e];
                        ss += __shfl_xor(ss, 1); ss += __shfl_xor(ss, 2); ss += __shfl_xor(ss, 4); ss += __shfl_xor(ss, 8);
                        if ((threadIdx.x & 15) == 0) ((float*)(ws + O_SSQC))[(size_t)row * 4 + (nt - 16)] = ss;
                    }
                } else if (col0_ < 64) {
                    float* kr = (float*)(ws + O_KIDXRAW) + (size_t)row * 64 + col0_;
                    *(float4*)kr = make_float4(v_[0], v_[1], v_[2], v_[3]);
                    *(float4*)(kr + 4) = make_float4(v_[4], v_[5], v_[6], v_[7]);
                } else if (col0_ < 80) {
                    float* wr = (float*)(ws + O_WIDX) + (size_t)row * 16 + (col0_ - 64);
                    const float sc = 1.f / 32.f;
                    *(float4*)wr = make_float4(v_[0] * sc, v_[1] * sc, v_[2] * sc, v_[3] * sc);
                    *(float4*)(wr + 4) = make_float4(v_[4] * sc, v_[5] * sc, v_[6] * sc, v_[7] * sc);
                }
            }
            __syncthreads();
        }
    }
}

template <bool PASS2>
DEV void s5_unit(const Params& P, int g, int c, unsigned char* wsm) {
    const int lane = threadIdx.x & 63;
    const int l31 = lane & 31, hl = lane >> 5;
    unsigned char* ws = P.ws;
    float* bu = (float*)wsm;
    const u16* U = (const u16*)(ws + O_U);
    const u16* bbt = (const u16*)(ws + O_BBT) + (size_t)g * 128 * 16;
    bf16x8 bb0 = *(const bf16x8*)(bbt + (0 * 32 + l31) * 16 + 8 * hl);
    bf16x8 bb1 = *(const bf16x8*)(bbt + (1 * 32 + l31) * 16 + 8 * hl);
    bf16x8 bb2 = *(const bf16x8*)(bbt + (2 * 32 + l31) * 16 + 8 * hl);
    bf16x8 bb3 = *(const bf16x8*)(bbt + (3 * 32 + l31) * 16 + 8 * hl);
    const float2 ab = ((const float2*)(ws + O_ABAR))[g * 64 + lane];
    const int rc = (lane >> 5) * 64 + l31, ic = rc + 32;
    bf16x8 cfr[8];
    bf16x8 dfr = {0, 0, 0, 0, 0, 0, 0, 0};
    if (PASS2) {
        const short dbf = (short)f2bf(P.d_skip[g * 16 + (l31 & 15)]);
#pragma unroll
        for (int j = 0; j < 8; ++j) dfr[j] = (l31 == 8 * hl + j) ? dbf : (short)0;
    }
    if (PASS2) {
        const u16* cct = (const u16*)(ws + O_CCT) + (size_t)g * 32 * 128;
#pragma unroll
        for (int ks = 0; ks < 8; ++ks) cfr[ks] = *(const bf16x8*)(cct + l31 * 128 + ks * 16 + 8 * hl);
    }
    float hr = 0.f, hi = 0.f;
    if (PASS2) {
        const float2 abT = ((const float2*)(ws + O_ABART))[g * 64 + lane];
        const float2* E = (const float2*)(ws + O_ENDST);
        for (int cc = 0; cc < c; ++cc) {
            const float2 e = E[((size_t)cc * 64 + g) * 64 + lane];
            const float t = abT.x * hr - abT.y * hi + e.x;
            hi = abT.x * hi + abT.y * hr + e.y;
            hr = t;
        }
    }
    bf16x8 ua_next = __builtin_nontemporal_load((const bf16x8*)(U + (size_t)(c * 256 + l31) * 1024 + g * 16 + 8 * hl));
    for (int st = 0; st < 8; ++st) {
        const int t0 = c * 256 + st * 32;
        const bf16x8 ua = ua_next;
        if (st + 1 < 8) ua_next = __builtin_nontemporal_load((const bf16x8*)(U + (size_t)(t0 + 32 + l31) * 1024 + g * 16 + 8 * hl));
        f32x16 z;
#pragma unroll
        for (int r = 0; r < 16; ++r) z[r] = 0.f;
        f32x16 c0 = __builtin_amdgcn_mfma_f32_32x32x16_bf16(ua, bb0, z, 0, 0, 0);
        f32x16 c1 = __builtin_amdgcn_mfma_f32_32x32x16_bf16(ua, bb1, z, 0, 0, 0);
        f32x16 c2 = __builtin_amdgcn_mfma_f32_32x32x16_bf16(ua, bb2, z, 0, 0, 0);
        f32x16 c3 = __builtin_amdgcn_mfma_f32_32x32x16_bf16(ua, bb3, z, 0, 0, 0);
        LDS_FENCE();
#pragma unroll
        for (int r = 0; r < 16; ++r) {
            const int row = (r & 3) + 8 * (r >> 2) + 4 * hl;
            bu[row * 132 + l31] = c0[r];
            bu[row * 132 + 32 + l31] = c1[r];
            bu[row * 132 + 64 + l31] = c2[r];
            bu[row * 132 + 96 + l31] = c3[r];
        }
        LDS_FENCE();
#pragma unroll
        for (int hb = 0; hb < 2; ++hb) {
            float vr[16], vi[16];
#pragma unroll
            for (int r = 0; r < 16; ++r) { vr[r] = bu[(hb * 16 + r) * 132 + rc]; vi[r] = bu[(hb * 16 + r) * 132 + ic]; }
            LDS_FENCE();
#pragma unroll
            for (int r = 0; r < 16; ++r) {
                const float t = ab.x * hr - ab.y * hi + vr[r];
                hi = ab.x * hi + ab.y * hr + vi[r];
                hr = t;
                if (PASS2) {
                    u16* hrow = (u16*)(bu + (hb * 16 + r) * 132);
                    hrow[rc] = f2bf(hr);
                    hrow[ic] = f2bf(hi);
                }
            }
        }
        if (PASS2) {
            LDS_FENCE();
            f32x16 y;
#pragma unroll
            for (int r = 0; r < 16; ++r) y[r] = 0.f;
#pragma unroll
            for (int ks = 0; ks < 8; ++ks) {
                const bf16x8 ha = *(const bf16x8*)((const unsigned char*)bu + l31 * 528 + (ks * 16 + 8 * hl) * 2);
                y = __builtin_amdgcn_mfma_f32_32x32x16_bf16(ha, cfr[ks], y, 0, 0, 0);
            }
            y = __builtin_amdgcn_mfma_f32_32x32x16_bf16(ua, dfr, y, 0, 0, 0);
            if (l31 < 16) {
#pragma unroll
                for (int r = 0; r < 16; ++r) {
                    const int tl = (r & 3) + 8 * (r >> 2) + 4 * hl;
                    ((u16*)((unsigned char*)bu + tl * 528 + 256))[l31] = f2bf(geluf_(y[r]));
                }
            }
            LDS_FENCE();
            if (lane < 32) {
                const uint4 y0 = *(const uint4*)((const unsigned char*)bu + lane * 528 + 256), y1 = *(const uint4*)((const unsigned char*)bu + lane * 528 + 272);
                u16* yp = (u16*)(ws + O_YACT) + (size_t)(t0 + lane) * 1024 + g * 16;
                typedef unsigned u32x4n __attribute__((ext_vector_type(4))); const u32x4n n0_ = {y0.x, y0.y, y0.z, y0.w}, n1_ = {y1.x, y1.y, y1.z, y1.w};
                __builtin_nontemporal_store(n0_, (u32x4n*)yp); __builtin_nontemporal_store(n1_, (u32x4n*)(yp + 8));
            }
            LDS_FENCE();
        }
    }
    if (!PASS2) ((float2*)(ws + O_ENDST))[((size_t)c * 64 + g) * 64 + lane] = make_float2(hr, hi);
}

DEV void phaseC(const Params& P, unsigned char* smem) {
    ACC_IDS
    const int tid = threadIdx.x, wid = tid >> 6;
    unsigned char* ws = P.ws;
    float* rinv_s = (float*)(smem + 65536);
    for (int job = blockIdx.x; job < 1024 + 32 + 512; job += gridDim.x) {
        if (job < 1024) {
            const int mt = job & 63, nt = job >> 6, m0 = mt * 128;
            const u16* cq = (const u16*)(ws + O_CQ);
            if (tid < 128) {
                const float4 q = *(const float4*)((const float*)(ws + O_SSQC) + (size_t)(m0 + tid) * 4);
                rinv_s[tid] = rsqrtf((q.x + q.y + q.z + q.w) * (1.f / 512.f) + 1e-6f);
            }
            f32x16 acc[2][2];
            ZERO_ACC(acc);
            gemm_mainloop(cq + (size_t)m0 * 512, 512, (const u16*)(ws + O_WUQ) + (size_t)nt * 128 * 512, 512, 512, smem, acc);
            u16* dst = (u16*)(ws + (nt < 8 ? O_Q : O_QIDX));
            const int cofs = (nt & 7) * 128;
            float* st = (float*)smem;
#pragma unroll 1
            for (int mi = 0; mi < 2; ++mi) {
                stage_half(acc, mi, st);
                FOR_CHUNKS(st) {
                    CHUNK_LOAD(st)
                    const int rl = SR_TO_ROW(sr_, mi);
                    const float ri = rinv_s[rl];
                    _Pragma("unroll") for (int e = 0; e < 8; ++e) v_[e] *= ri;
                    { const uint4 pk_ = pack8(v_); const u32x4nt t_ = {pk_.x, pk_.y, pk_.z, pk_.w}; __builtin_nontemporal_store(t_, (u32x4nt*)(dst + (size_t)(m0 + rl) * 1024 + cofs + col0_)); }
                }
                __syncthreads();
            }
        } else if (job < 1056) {
            const int row = (job - 1024) * 256 + tid;
            const float4* kr = (const float4*)((const float*)(ws + O_KIDXRAW) + (size_t)row * 64);
            float4 v[16];
            float ss = 0.f;
#pragma unroll
            for (int i = 0; i < 16; ++i) { v[i] = kr[i]; ss += v[i].x * v[i].x + v[i].y * v[i].y + v[i].z * v[i].z + v[i].w * v[i].w; }
            const float rinv = rsqrtf(ss * (1.f / 64.f) + 1e-6f);
            const float4* gk = (const float4*)P.g_kidx;
            u16* o = (u16*)(ws + O_KIDX) + (size_t)(row >> 5) * 2048 + (row & 31) * 8;
#pragma unroll
            for (int i = 0; i < 16; ++i) {
                const float4 g = gk[i];
                uint2 w; w.x = pack2(v[i].x * rinv * g.x, v[i].y * rinv * g.y); w.y = pack2(v[i].z * rinv * g.z, v[i].w * rinv * g.w);
                *(uint2*)(o + (i >> 1) * 256 + (i & 1) * 4) = w;
            }
        } else {
            const int unit = (job - 1056) * 4 + wid;
            s5_unit<false>(P, unit & 63, unit >> 6, smem + wid * 16896);
        }
    }
}

constexpr int RW = 8208;
constexpr uint32_t PADKEY = 0x0EB60D35u;
DEV int bucket_of(float sc) { return (int)fminf(fmaxf((sc + 4.f) * 32.f, 0.f), 255.f); }
DEV float key2f(uint32_t k) { return __uint_as_float((k & 0x80000000u) ? (k ^ 0x80000000u) : ~k); }
DEV int bucket_of_key(uint32_t k) { return (k == PADKEY) ? -1 : bucket_of(key2f(k)); }
DEV uint32_t first_key_with_bucket(int bt) {
    const int lane = threadIdx.x & 63;
    uint32_t lo = PADKEY, hi = 0xFF800000u;
    while (hi - lo > 1u) {
        const uint32_t span = hi - lo, step = (span + 63u) >> 6;
        const unsigned long long off = (unsigned long long)step * (unsigned)(lane + 1);
        const uint32_t cand = (off >= span) ? hi : lo + (uint32_t)off;
        const bool pr = bucket_of_key(cand) >= bt;
        const int f = __ffsll((long long)__ballot(pr)) - 1;
        const uint32_t nhi = (uint32_t)__shfl((int)cand, f);
        const unsigned long long offl = (unsigned long long)step * (unsigned)f;
        const uint32_t nlo = (f == 0) ? lo : ((offl >= span) ? hi : lo + (uint32_t)offl);
        hi = nhi; lo = nlo;
    }
    return hi;
}
DEV uint32_t f2key(float f) { const uint32_t u = __float_as_uint(f); return u ^ ((uint32_t)((int32_t)u >> 31) | 0x80000000u); }

DEV void idx_score_tile(const bf16x8 (&a)[4], const bf16x8 (&b)[4], const float (&w)[16], float& p0, float& p1) {
    f32x16 acc;
#pragma unroll
    for (int r = 0; r < 16; ++r) acc[r] = 0.f;
#pragma unroll
    for (int ks = 0; ks < 4; ++ks) acc = __builtin_amdgcn_mfma_f32_32x32x16_bf16(a[ks], b[ks], acc, 0, 0, 0);
    p0 = 0.f; p1 = 0.f;
#pragma unroll
    for (int r = 0; r < 8; ++r) { p0 += w[r] * fmaxf(acc[r], 0.f); p1 += w[r + 8] * fmaxf(acc[r + 8], 0.f); }
    typedef unsigned u32x2_ __attribute__((ext_vector_type(2)));
    const u32x2_ sw = __builtin_amdgcn_permlane32_swap(__float_as_uint(p0), __float_as_uint(p1), false, false);
    p0 = __uint_as_float(sw[0]) + __uint_as_float(sw[1]);
    p1 = p0;
}

DEV void attn_job(const Params& P, int j, int rot, unsigned char* smem) {
    const int tid = threadIdx.x, lane = tid & 63, wid = tid >> 6;
    const int l31 = lane & 31, hl = lane >> 5;
    unsigned char* ws = P.ws;
    uint32_t* rows = (uint32_t*)smem;
    uint32_t* hist_all = (uint32_t*)(smem + 2 * RW * 4);
    const int tl0 = 2 * j, tl1 = 2 * j + 1, th0 = 8190 - 2 * j, th1 = 8191 - 2 * j;
    uint32_t* rowL0 = rows;
    uint32_t* rowH1 = rows + ((tl0 + 4) & ~3);
    uint32_t* rowL1 = rows + RW;
    uint32_t* rowH0 = rows + RW + ((tl1 + 4) & ~3);
    const int role = wid ^ ((rot & 1) << 1);
    hist_all[tid] = 0u; hist_all[tid + 256] = 0u; hist_all[tid + 512] = 0u; hist_all[tid + 768] = 0u;
    __syncthreads();
    const u16* QI = (const u16*)(ws + O_QIDX);
    const u16* KI = (const u16*)(ws + O_KIDX);
    const float* WI = (const float*)(ws + O_WIDX);
    for (int rep1 = 0; rep1 < (PROBE_SEC == 1 ? 2 : 1); ++rep1) {
        bf16x8 aL[4], aH[4];
        float wL[16], wH[16];
        {
            const int qi = l31 >> 4, head = l31 & 15;
            const u16* pl = QI + (size_t)(qi ? tl1 : tl0) * 1024 + head * 64 + 8 * hl;
            const u16* ph = QI + (size_t)(qi ? th1 : th0) * 1024 + head * 64 + 8 * hl;
#pragma unroll
            for (int ks = 0; ks < 4; ++ks) { aL[ks] = __builtin_nontemporal_load((const bf16x8*)(pl + ks * 16)); aH[ks] = __builtin_nontemporal_load((const bf16x8*)(ph + ks * 16)); }
#pragma unroll
            for (int r = 0; r < 16; ++r) {
                const int q = r >> 3, hd = (r & 3) + 8 * ((r >> 2) & 1) + 4 * hl;
                wL[r] = WI[(size_t)(q ? tl1 : tl0) * 16 + hd];
                wH[r] = WI[(size_t)(q ? th1 : th0) * 16 + hd];
            }
        }
        const int nkt = (th1 >> 5) + 1;
        bf16x8 bq[3][4];
#define KLOAD(u, ktv) { const int kc_ = min((ktv), nkt - 1); const u16* kp_ = KI + (size_t)kc_ * 2048 + hl * 256 + l31 * 8; \
            _Pragma("unroll") for (int ks = 0; ks < 4; ++ks) bq[u][ks] = *(const bf16x8*)(kp_ + ks * 512); }
        uint32_t* const rowHs = hl ? rowH1 : rowH0; const int tHs = hl ? th1 : th0; uint32_t* const hHs = hist_all + (2 + hl) * 256;
        uint32_t* const rowLs = hl ? rowL1 : rowL0; const int tLs = hl ? tl1 : tl0; uint32_t* const hLs = hist_all + hl * 256;
#define ROWPUT(rowp, hp, tq, pv) if (key < (((tq) + 4) & ~3)) { const bool ok_ = key <= (tq); rowp[key] = ok_ ? f2key(pv) : PADKEY; if (ok_) atomicAdd(&hp[bucket_of(pv)], 1u); }
#define KTILE(u, ktv) if ((ktv) < nkt) { const int key = (ktv) * 32 + l31; float p0, p1; \
            idx_score_tile(aH, bq[u], wH, p0, p1); \
            ROWPUT(rowHs, hHs, tHs, p0) \
            if ((ktv) * 32 <= tl1) { idx_score_tile(aL, bq[u], wL, p0, p1); ROWPUT(rowLs, hLs, tLs, p0) } }
        KLOAD(0, wid) KLOAD(1, wid + 4) KLOAD(2, wid + 8)
        for (int kt = wid; kt < nkt; kt += 12) {
            KTILE(0, kt) KLOAD(0, kt + 12)
            KTILE(1, kt + 4) KLOAD(1, kt + 16)
            KTILE(2, kt + 8) KLOAD(2, kt + 20)
        }
#undef KLOAD
#undef KTILE
#undef ROWPUT
    }
    __syncthreads();
    uint32_t* row; int t;
    if (role == 0) { row = rowL0; t = tl0; } else if (role == 1) { row = rowL1; t = tl1; } else if (role == 2) { row = rowH0; t = th0; } else { row = rowH1; t = th1; }
    const int n = t + 1;
    uint32_t* hrow = hist_all + role * 256;
    u16* idxl = (u16*)hrow;
    u16* cand = idxl + 256;
    int nsel;
    for (int rep2 = 0; rep2 < (PROBE_SEC == 2 ? 2 : 1); ++rep2)
    if (n <= 256) {
        nsel = n;
        LDS_FENCE();
        for (int i = lane; i < 256; i += 64) idxl[i] = (u16)((i < n) ? i : 0);
    } else {
        nsel = 256;
        int b0; uint32_t kkb, cntb;
        {
            const uint32_t c0 = hrow[255 - 4 * lane], c1 = hrow[254 - 4 * lane], c2 = hrow[253 - 4 * lane], c3 = hrow[252 - 4 * lane];
            const uint32_t sm = c0 + c1 + c2 + c3;
            uint32_t incl = sm;
#pragma unroll
            for (int d = 1; d < 64; d <<= 1) { const uint32_t v = __shfl_up(incl, d); if (lane >= d) incl += v; }
            uint32_t e = incl - sm;
            const bool hit = (e < 256u) && (256u <= incl);
            const int srcl = __ffsll((long long)__ballot(hit)) - 1;
            int bin; uint32_t nk, cb;
            if (e + c0 >= 256u) { bin = 255 - 4 * lane; nk = 256u - e; cb = c0; }
            else { e += c0; if (e + c1 >= 256u) { bin = 254 - 4 * lane; nk = 256u - e; cb = c1; }
            else { e += c1; if (e + c2 >= 256u) { bin = 253 - 4 * lane; nk = 256u - e; cb = c2; }
            else { e += c2; bin = 252 - 4 * lane; nk = 256u - e; cb = c3; } } }
            b0 = __shfl(bin, srcl); kkb = __shfl(nk, srcl); cntb = __shfl(cb, srcl);
        }
        LDS_FENCE();
        if (cntb <= 256u) {
            const int n4 = (n + 3) & ~3;
            const int ngt = 256 - (int)kkb;
            const uint32_t khi = (b0 >= 255) ? 0xFFFFFFFFu : first_key_with_bucket(b0 + 1);
            const uint32_t klo = (b0 <= 0) ? (PADKEY + 1u) : first_key_with_bucket(b0);
            uint32_t cg = 0, ce = 0;
            for (int i4 = lane * 4; i4 < n4; i4 += 256) {
                const uint4 k4 = *(const uint4*)(row + i4);
                cg += (k4.x >= khi) + (k4.y >= khi) + (k4.z >= khi) + (k4.w >= khi);
                ce += (k4.x >= klo) + (k4.y >= klo) + (k4.z >= klo) + (k4.w >= klo);
            }
            ce -= cg;
            uint32_t ig = cg, ie = ce;
#pragma unroll
            for (int d = 1; d < 64; d <<= 1) {
                const uint32_t vg = __shfl_up(ig, d), ve = __shfl_up(ie, d);
                if (lane >= d) { ig += vg; ie += ve; }
            }
            uint32_t bg = ig - cg, be = ie - ce;
            for (int i4 = lane * 4; i4 < n4; i4 += 256) {
                const uint4 k4 = *(const uint4*)(row + i4);
                const uint32_t kv[4] = {k4.x, k4.y, k4.z, k4.w};
#pragma unroll
                for (int e = 0; e < 4; ++e) {
                    if (kv[e] >= khi) { idxl[bg] = (u16)(i4 + e); ++bg; }
                    else if (kv[e] >= klo) { cand[be] = (u16)(i4 + e); ++be; }
                }
            }
            LDS_FENCE();
            uint32_t ck[4]; int ci[4];
#pragma unroll
            for (int c = 0; c < 4; ++c) { const int q = lane + 64 * c; ci[c] = (q < (int)cntb) ? (int)cand[q] : 0; }
#pragma unroll
            for (int c = 0; c < 4; ++c) ck[c] = row[ci[c]];
            LDS_FENCE();
#pragma unroll
            for (int c = 0; c < 4; ++c) { const int q = lane + 64 * c; if (q < (int)cntb) row[q] = ck[c]; }
            LDS_FENCE();
            uint32_t rk[4] = {0u, 0u, 0u, 0u};
            for (int jq = 0; jq < (int)cntb; ++jq) {
                const uint32_t kj = row[jq];
#pragma unroll
                for (int c = 0; c < 4; ++c) rk[c] += ((kj > ck[c]) || (kj == ck[c] && jq < lane + 64 * c)) ? 1u : 0u;
            }
#pragma unroll
            for (int c = 0; c < 4; ++c) { const int q = lane + 64 * c; if (q < (int)cntb && rk[c] < kkb) idxl[ngt + rk[c]] = (u16)ci[c]; }
        } else {
        uint32_t prefix = 0, kk = 256;
        for (int pass = 0; pass < 4; ++pass) {
            const int shift = 24 - 8 * pass;
            hrow[lane] = 0; hrow[lane + 64] = 0; hrow[lane + 128] = 0; hrow[lane + 192] = 0;
            LDS_FENCE();
            const int n4 = (n + 3) & ~3;
            if (pass == 0) {
                for (int i4 = lane * 4; i4 < n4; i4 += 256) {
                    const uint4 k4 = *(const uint4*)(row + i4);
                    atomicAdd(&hrow[k4.x >> 24], 1u); atomicAdd(&hrow[k4.y >> 24], 1u); atomicAdd(&hrow[k4.z >> 24], 1u); atomicAdd(&hrow[k4.w >> 24], 1u);
                }
            } else {
                const int sh8 = shift + 8;
                for (int i4 = lane * 4; i4 < n4; i4 += 256) {
                    const uint4 k4 = *(const uint4*)(row + i4);
                    if ((k4.x >> sh8) == prefix) atomicAdd(&hrow[(k4.x >> shift) & 255u], 1u);
                    if ((k4.y >> sh8) == prefix) atomicAdd(&hrow[(k4.y >> shift) & 255u], 1u);
                    if ((k4.z >> sh8) == prefix) atomicAdd(&hrow[(k4.z >> shift) & 255u], 1u);
                    if ((k4.w >> sh8) == prefix) atomicAdd(&hrow[(k4.w >> shift) & 255u], 1u);
                }
            }
            LDS_FENCE();
            const uint32_t c0 = hrow[255 - 4 * lane], c1 = hrow[254 - 4 * lane], c2 = hrow[253 - 4 * lane], c3 = hrow[252 - 4 * lane];
            const uint32_t s = c0 + c1 + c2 + c3;
            uint32_t incl = s;
#pragma unroll
            for (int d = 1; d < 64; d <<= 1) { const uint32_t v = __shfl_up(incl, d); if (lane >= d) incl += v; }
            uint32_t e = incl - s;
            const bool hit = (e < kk) && (kk <= incl);
            const unsigned long long bm = __ballot(hit);
            const int srcl = __ffsll((long long)bm) - 1;
            int bin; uint32_t nk;
            if (e + c0 >= kk) { bin = 255 - 4 * lane; nk = kk - e; }
            else { e += c0; if (e + c1 >= kk) { bin = 254 - 4 * lane; nk = kk - e; }
            else { e += c1; if (e + c2 >= kk) { bin = 253 - 4 * lane; nk = kk - e; }
            else { e += c2; bin = 252 - 4 * lane; nk = kk - e; } } }
            bin = __shfl(bin, srcl);
            nk = __shfl(nk, srcl);
            prefix = (prefix << 8) | (uint32_t)bin;
            kk = nk;
            LDS_FENCE();
        }
        const uint32_t T = prefix;
        const int ngt = 256 - (int)kk;
        const int n4 = (n + 3) & ~3;
        uint32_t cg = 0, ce = 0;
        for (int i4 = lane * 4; i4 < n4; i4 += 256) {
            const uint4 k4 = *(const uint4*)(row + i4);
            cg += (k4.x > T) + (k4.y > T) + (k4.z > T) + (k4.w > T);
            ce += (k4.x == T) + (k4.y == T) + (k4.z == T) + (k4.w == T);
        }
        uint32_t ig = cg, ie = ce;
#pragma unroll
        for (int d = 1; d < 64; d <<= 1) {
            const uint32_t vg = __shfl_up(ig, d), ve = __shfl_up(ie, d);
            if (lane >= d) { ig += vg; ie += ve; }
        }
        uint32_t bg = ig - cg, be = ie - ce;
        for (int i4 = lane * 4; i4 < n4; i4 += 256) {
            const uint4 k4 = *(const uint4*)(row + i4);
            const uint32_t kv[4] = {k4.x, k4.y, k4.z, k4.w};
#pragma unroll
            for (int e = 0; e < 4; ++e) {
                if (kv[e] > T) { idxl[bg] = (u16)(i4 + e); ++bg; }
                else if (kv[e] == T) { if (be < kk) idxl[ngt + be] = (u16)(i4 + e); ++be; }
            }
        }
        }
    }
    __syncthreads();
    float* lg = (float*)(smem + ((role == 0 || role == 3) ? 0 : RW * 4) + ((role >= 2) ? (RW * 2) : 0));
    const u16* Qp = (const u16*)(ws + O_Q) + (size_t)t * 1024;
    const u16* Kb = (const u16*)(ws + O_K);
    const u16* Vb = (const u16*)(ws + O_V);
    const int l15 = lane & 15, q4 = lane >> 4;
    const float scale = 0.08838834764831845f;
    unsigned char* scr = (unsigned char*)lg;
    for (int rep3 = 0; rep3 < (PROBE_SEC == 3 ? 2 : 1); ++rep3) {
    {
        unsigned char* ktile = scr + 8192;
        unsigned kwofs[8], krd[2][4];
#pragma unroll
        for (int i = 0; i < 8; ++i) { const unsigned row = q4 + 4 * i, ch = l15; kwofs[i] = 256u * row + 16u * (ch ^ (((row & 3) << 2) | ((row >> 2) & 3))); }
#pragma unroll
        for (int rb = 0; rb < 2; ++rb)
#pragma unroll
            for (int sx = 0; sx < 4; ++sx) { const unsigned row = l15 + 16 * rb, ch = 4 * sx + q4; krd[rb][sx] = 256u * row + 16u * (ch ^ (((row & 3) << 2) | ((row >> 2) & 3))); }
        uint4 kr0, kr1, kr2, kr3, kr4, kr5, kr6, kr7;
#define KLD1(i, dst) { const int key = idxl[ck_ * 32 + q4 + 4 * (i)]; dst = *(const uint4*)(Kb + (size_t)key * 256 + g_ * 128 + l15 * 8); }
#define KGLOAD(it_) { const int g_ = (it_) >> 3, ck_ = (it_) & 7; KLD1(0, kr0) KLD1(1, kr1) KLD1(2, kr2) KLD1(3, kr3) KLD1(4, kr4) KLD1(5, kr5) KLD1(6, kr6) KLD1(7, kr7) }
        KGLOAD(0)
#pragma unroll 1
        for (int g = 0; g < 2; ++g) {
            bf16x8 qa[4];
#pragma unroll
            for (int ks = 0; ks < 4; ++ks) {
                bf16x8 z = {0, 0, 0, 0, 0, 0, 0, 0};
                qa[ks] = z;
                if (l15 < 4) qa[ks] = __builtin_nontemporal_load((const bf16x8*)(Qp + (g * 4 + l15) * 128 + ks * 32 + 8 * q4));
            }
#pragma unroll 1
            for (int ck = 0; ck < 8; ++ck) {
                const int it = g * 8 + ck;
                *(uint4*)(ktile + kwofs[0]) = kr0; *(uint4*)(ktile + kwofs[1]) = kr1; *(uint4*)(ktile + kwofs[2]) = kr2; *(uint4*)(ktile + kwofs[3]) = kr3;
                *(uint4*)(ktile + kwofs[4]) = kr4; *(uint4*)(ktile + kwofs[5]) = kr5; *(uint4*)(ktile + kwofs[6]) = kr6; *(uint4*)(ktile + kwofs[7]) = kr7;
                if (it + 1 < 16) KGLOAD(it + 1)
                LDS_FENCE();
#pragma unroll
                for (int rb = 0; rb < 2; ++rb) {
                    f32x4 acc = {0.f, 0.f, 0.f, 0.f};
#pragma unroll
                    for (int sx = 0; sx < 4; ++sx) {
                        const bf16x8 kb = *(const bf16x8*)(ktile + krd[rb][sx]);
                        acc = __builtin_amdgcn_mfma_f32_16x16x32_bf16(qa[sx], kb, acc, 0, 0, 0);
                    }
                    if (lane < 16) {
                        const int kidx = ck * 32 + rb * 16 + lane;
                        const bool ok = kidx < nsel;
#pragma unroll
                        for (int r = 0; r < 4; ++r) lg[(g * 4 + r) * 256 + kidx] = ok ? acc[r] * scale : -INFINITY;
                    }
                }
                LDS_FENCE();
            }
        }
#undef KGLOAD
#undef KLD1
    }
    LDS_FENCE();
    {
        uint2 pk[8];
#pragma unroll
        for (int hh = 0; hh < 8; ++hh) {
            const float4 x = *(const float4*)(lg + hh * 256 + 4 * lane);
            float m = wave_max_fast(fmaxf(fmaxf(x.x, x.y), fmaxf(x.z, x.w)));
            const float e0 = __expf(x.x - m), e1 = __expf(x.y - m), e2 = __expf(x.z - m), e3 = __expf(x.w - m);
            const float inv = 1.f / wave_sum_fast(e0 + e1 + e2 + e3);
            pk[hh].x = pack2(e0 * inv, e1 * inv);
            pk[hh].y = pack2(e2 * inv, e3 * inv);
        }
        LDS_FENCE();
#pragma unroll
        for (int hh = 0; hh < 8; ++hh) *(uint2*)(scr + hh * 512 + lane * 8) = pk[hh];
    }
    }
    LDS_FENCE();
    for (int rep4 = 0; rep4 < (PROBE_SEC == 4 ? 2 : 1); ++rep4) {
        unsigned char* vt = scr + 8192;
        const int q = l15 >> 2, p = l15 & 3;
        unsigned tra[8][2];
#pragma unroll
        for (int c = 0; c < 8; ++c)
#pragma unroll
            for (int tt = 0; tt < 2; ++tt) {
                const unsigned row = 8 * q4 + 4 * tt + q, ch = 2 * c + (p >> 1);
                tra[c][tt] = 256u * row + 16u * (ch ^ (((row & 3) << 2) | ((row >> 2) & 3))) + 8 * (p & 1);
            }
        unsigned wofs[8];
#pragma unroll
        for (int i = 0; i < 8; ++i) {
            const unsigned row = q4 + 4 * i, ch = l15;
            wofs[i] = 256u * row + 16u * (ch ^ (((row & 3) << 2) | ((row >> 2) & 3)));
        }
        uint4 vr0, vr1, vr2, vr3, vr4, vr5, vr6, vr7;
#define VLD1(i, dst) { const int key = idxl[ck_ * 32 + q4 + 4 * (i)]; dst = *(const uint4*)(Vb + (size_t)key * 256 + g_ * 128 + l15 * 8); }
#define VLOAD(it_) { const int g_ = (it_) >> 3, ck_ = (it_) & 7; VLD1(0, vr0) VLD1(1, vr1) VLD1(2, vr2) VLD1(3, vr3) VLD1(4, vr4) VLD1(5, vr5) VLD1(6, vr6) VLD1(7, vr7) }
        VLOAD(0)
        const u16* za = (const u16*)(ws + O_ZA) + (size_t)t * 1024;
        u16* ya = (u16*)(ws + O_YATT) + (size_t)t * 1024;
#pragma unroll 1
        for (int g = 0; g < 2; ++g) {
            f32x4 oacc[8];
#pragma unroll
            for (int c = 0; c < 8; ++c) { f32x4 z = {0.f, 0.f, 0.f, 0.f}; oacc[c] = z; }
#pragma unroll 1
            for (int ck = 0; ck < 8; ++ck) {
                const int it = g * 8 + ck;
                *(uint4*)(vt + wofs[0]) = vr0; *(uint4*)(vt + wofs[1]) = vr1; *(uint4*)(vt + wofs[2]) = vr2; *(uint4*)(vt + wofs[3]) = vr3;
                *(uint4*)(vt + wofs[4]) = vr4; *(uint4*)(vt + wofs[5]) = vr5; *(uint4*)(vt + wofs[6]) = vr6; *(uint4*)(vt + wofs[7]) = vr7;
                if (it + 1 < 16) VLOAD(it + 1)
                LDS_FENCE();
                const bf16x8 pa = *(const bf16x8*)(scr + (g * 4 + l15) * 512 + (ck * 32 + 8 * q4) * 2);
#pragma unroll
                for (int c = 0; c < 8; ++c) {
                    typedef short s16x4 __attribute__((ext_vector_type(4)));
                    const s16x4 lo = __builtin_amdgcn_ds_read_tr16_b64_v4i16((__attribute__((address_space(3))) s16x4*)(vt + tra[c][0]));
                    const s16x4 hi = __builtin_amdgcn_ds_read_tr16_b64_v4i16((__attribute__((address_space(3))) s16x4*)(vt + tra[c][1]));
                    const bf16x8 vb = {lo[0], lo[1], lo[2], lo[3], hi[0], hi[1], hi[2], hi[3]};
                    oacc[c] = __builtin_amdgcn_mfma_f32_16x16x32_bf16(pa, vb, oacc[c], 0, 0, 0);
                }
                LDS_FENCE();
            }
            if (lane < 16) {
#pragma unroll
                for (int c = 0; c < 8; ++c)
#pragma unroll
                    for (int r = 0; r < 4; ++r) {
                        const int cb = (g * 4 + r) * 128 + c * 16 + lane;
                        __builtin_nontemporal_store(f2bf(oacc[c][r] * bf2f(__builtin_nontemporal_load(za + cb))), ya + cb);
                    }
            }
        }
#undef VLOAD
#undef VLD1
    }
    __syncthreads();
}

DEV void phaseD(const Params& P, unsigned char* smem) {
    const int wid = threadIdx.x >> 6;
    const int G = gridDim.x;
    const bool s5_last = (blockIdx.x >> 3) & 1;
    if (!s5_last) {
        for (int job = blockIdx.x; job < 512; job += G) {
            const int unit = job * 4 + wid;
            for (int rep5 = 0; rep5 < (PROBE_SEC == 5 ? 2 : 1); ++rep5) s5_unit<true>(P, unit & 63, unit >> 6, smem + wid * 16896);
            __syncthreads();
        }
    }
    for (int aj = blockIdx.x; aj < 2048; aj += G) attn_job(P, aj, aj / G, smem);
    if (s5_last) {
        for (int job = blockIdx.x; job < 512; job += G) {
            const int unit = job * 4 + wid;
            s5_unit<true>(P, unit & 63, unit >> 6, smem + wid * 16896);
            __syncthreads();
        }
    }
}

DEV void phaseE(const Params& P, unsigned char* smem) {
    ACC_IDS
    unsigned char* ws = P.ws;
    for (int job = blockIdx.x; job < 1024; job += gridDim.x) {
        const int mt = job & 63, nt = job >> 6, m0 = mt * 128;
        f32x16 acc[2][2];
        ZERO_ACC(acc);
        gemm_mainloop((const u16*)(ws + O_YACT) + (size_t)m0 * 1024, 1024, (const u16*)(ws + O_WGLU) + (size_t)nt * 128 * 1024, 1024, 1024, smem, acc);
        const u16* zs = (const u16*)(ws + O_ZS);
        u16* ys = (u16*)(ws + O_U);
        float* st = (float*)smem;
        uint4 zpre[2][2];
#pragma unroll
        for (int mi = 0; mi < 2; ++mi)
#pragma unroll
            for (int i = 0; i < 2; ++i) {
                const int cid = threadIdx.x + 256 * i, sr = cid >> 3, ac = cid & 7;
                zpre[mi][i] = ld_nt16(zs + (size_t)(m0 + SR_TO_ROW(sr, mi)) * 1024 + nt * 64 + (ac >> 2) * 32 + (ac & 3) * 8);
            }
#pragma unroll
        for (int mi = 0; mi < 2; ++mi) {
            stage_half(acc, mi, st);
#pragma unroll
            for (int i = 0; i < 2; ++i) {
                const int cid = threadIdx.x + 256 * i;
                const int sr = cid >> 3, ac = cid & 7;
                const int tcol = (ac >> 2) * 64 + (ac & 3) * 8;
                const int row = m0 + SR_TO_ROW(sr, mi);
                const int ocol = nt * 64 + (ac >> 2) * 32 + (ac & 3) * 8;
                const float4 a0 = *(const float4*)(st + sr * 132 + tcol), a1 = *(const float4*)(st + sr * 132 + tcol + 4);
                const float4 b0 = *(const float4*)(st + sr * 132 + tcol + 32), b1 = *(const float4*)(st + sr * 132 + tcol + 36);
                float z[8];
                unpack8(zpre[mi][i], z);
                float o[8];
                o[0] = a0.x * sigmoidf_(b0.x) * z[0]; o[1] = a0.y * sigmoidf_(b0.y) * z[1]; o[2] = a0.z * sigmoidf_(b0.z) * z[2]; o[3] = a0.w * sigmoidf_(b0.w) * z[3];
                o[4] = a1.x * sigmoidf_(b1.x) * z[4]; o[5] = a1.y * sigmoidf_(b1.y) * z[5]; o[6] = a1.z * sigmoidf_(b1.z) * z[6]; o[7] = a1.w * sigmoidf_(b1.w) * z[7];
                *(uint4*)(ys + (size_t)row * 1024 + ocol) = pack8(o);
            }
            __syncthreads();
        }
    }
}

DEV void phaseF(const Params& P, unsigned char* smem) {
    ACC_IDS
    unsigned char* ws = P.ws;
    const int ntile = (1024 - (int)blockIdx.x + (int)gridDim.x - 1) / (int)gridDim.x;
    uint4 part[2][4];
    for (int q = 0; q < 2 * ntile; ++q) {
        const int job = blockIdx.x + (q >> 1) * gridDim.x, pass = q & 1;
        const int mt = job & 63, nt = job >> 6, m0 = mt * 128, n0 = nt * 128;
        f32x16 acc[2][2];
        ZERO_ACC(acc);
        const u16* A = (const u16*)(ws + (pass ? O_YATT : O_U)) + (size_t)m0 * 1024;
        const u16* B = (const u16*)(ws + (pass ? O_WATTO : O_WSSMO)) + (size_t)n0 * 1024;
        gemm_mainloop(A, 1024, B, 1024, 1024, smem, acc);
        const u16* gt = (const u16*)(ws + (pass ? O_GA : O_GS));
        u16* mg = (u16*)(ws + O_MERGED);
        float* st = (float*)smem;
        uint4 gpre[2][4];
#pragma unroll
        for (int mi = 0; mi < 2; ++mi)
#pragma unroll
            for (int i_ = 0; i_ < 4; ++i_) {
                const int cid_ = threadIdx.x + 256 * i_, sr_ = cid_ >> 4, col0_ = (cid_ & 15) * 8;
                gpre[mi][i_] = ld_nt16(gt + (size_t)(m0 + SR_TO_ROW(sr_, mi)) * 2048 + n0 + col0_);
            }
#pragma unroll
        for (int mi = 0; mi < 2; ++mi) {
            stage_half(acc, mi, st);
#pragma unroll
            for (int i_ = 0; i_ < 4; ++i_) {
                CHUNK_LOAD(st)
                const size_t o = (size_t)(m0 + SR_TO_ROW(sr_, mi)) * 2048 + n0 + col0_;
                float g[8];
                unpack8(gpre[mi][i_], g);
                _Pragma("unroll") for (int e = 0; e < 8; ++e) v_[e] *= g[e];
                if (pass) {
                    float pvv[8];
                    unpack8(part[mi][i_], pvv);
                    _Pragma("unroll") for (int e = 0; e < 8; ++e) v_[e] += pvv[e];
                    *(uint4*)(mg + o) = pack8(v_);
                } else {
                    part[mi][i_] = pack8(v_);
                }
            }
            __syncthreads();
        }
    }
}

DEV void phaseG(const Params& P, unsigned char* smem) {
    ACC_IDS
    unsigned char* ws = P.ws;
    for (int job = blockIdx.x; job < 1024; job += gridDim.x) {
        const int mt = job & 63, nt = job >> 6, m0 = mt * 128, n0 = nt * 128;
        f32x16 acc[2][2];
        ZERO_ACC(acc);
        gemm_mainloop((const u16*)(ws + O_MERGED) + (size_t)m0 * 2048, 2048, (const u16*)(ws + O_WO) + (size_t)n0 * 2048, 2048, 2048, smem, acc);
        u16* xb = (u16*)(ws + O_X1B);
        float* ssq = (float*)(ws + O_SSQ1);
        float* st = (float*)smem;
#pragma unroll 1
        for (int mi = 0; mi < 2; ++mi) {
            stage_half(acc, mi, st);
            FOR_CHUNKS(st) {
                CHUNK_LOAD(st)
                const int row = m0 + SR_TO_ROW(sr_, mi);
                const size_t o = (size_t)row * 2048 + n0 + col0_;
                const float4 x0 = *(const float4*)(P.x + o), x1 = *(const float4*)(P.x + o + 4);
                v_[0] += x0.x; v_[1] += x0.y; v_[2] += x0.z; v_[3] += x0.w; v_[4] += x1.x; v_[5] += x1.y; v_[6] += x1.z; v_[7] += x1.w;
                *(float4*)(P.out + o) = make_float4(v_[0], v_[1], v_[2], v_[3]);
                *(float4*)(P.out + o + 4) = make_float4(v_[4], v_[5], v_[6], v_[7]);
                *(uint4*)(xb + o) = pack8(v_);
                float ss = 0.f;
                _Pragma("unroll") for (int e = 0; e < 8; ++e) ss += v_[e] * v_[e];
                ss += __shfl_xor(ss, 1); ss += __shfl_xor(ss, 2); ss += __shfl_xor(ss, 4); ss += __shfl_xor(ss, 8);
                if ((threadIdx.x & 15) == 0) ssq[(size_t)row * 16 + nt] = ss;
            }
            __syncthreads();
        }
    }
}

DEV void phaseH(const Params& P, unsigned char* smem) {
    ACC_IDS
    const int tid = threadIdx.x;
    unsigned char* ws = P.ws;
    float* rinv_s = (float*)(smem + 65536);
    for (int job = blockIdx.x; job < 2048; job += gridDim.x) {
        const int jj = job & 1023;
        const int mt = jj & 63, nt = jj >> 6, m0 = mt * 128, n0 = nt * 128;
        f32x16 acc[2][2];
        ZERO_ACC(acc);
        if (job < 1024) {
            {
                const int row = tid >> 1, half = tid & 1;
                const float4* sp = (const float4*)((const float*)(ws + O_SSQ1) + (size_t)(m0 + row) * 16 + half * 8);
                float ss = 0.f;
#pragma unroll
                for (int i = 0; i < 2; ++i) { const float4 q = sp[i]; ss += q.x + q.y + q.z + q.w; }
                ss += __shfl_xor(ss, 1);
                if (half == 0) rinv_s[row] = rsqrtf(ss * (1.f / 2048.f) + 1e-6f);
            }
            gemm_mainloop((const u16*)(ws + O_X1B) + (size_t)m0 * 2048, 2048, (const u16*)(ws + O_WPG) + (size_t)n0 * 2048, 2048, 2048, smem, acc);
            u16* gt = (u16*)(ws + O_GS);
            float* st = (float*)smem;
#pragma unroll 1
            for (int mi = 0; mi < 2; ++mi) {
                stage_half(acc, mi, st);
                FOR_CHUNKS(st) {
                    CHUNK_LOAD(st)
                    const int rl = SR_TO_ROW(sr_, mi);
                    const float ri = rinv_s[rl];
                    _Pragma("unroll") for (int e = 0; e < 8; ++e) v_[e] = sigmoidf_(v_[e] * ri);
                    *(uint4*)(gt + (size_t)(m0 + rl) * 2048 + n0 + col0_) = pack8(v_);
                }
                __syncthreads();
            }
        } else {
            gemm_mainloop((const u16*)(ws + O_PBF) + (size_t)m0 * 256, 256, (const u16*)(ws + O_WPLE) + (size_t)n0 * 256, 256, 256, smem, acc);
            u16* er = (u16*)(ws + O_GA);
            float* ssq = (float*)(ws + O_SSQE);
            float* st = (float*)smem;
#pragma unroll 1
            for (int mi = 0; mi < 2; ++mi) {
                stage_half(acc, mi, st);
                FOR_CHUNKS(st) {
                    CHUNK_LOAD(st)
                    const int row = m0 + SR_TO_ROW(sr_, mi);
                    *(uint4*)(er + (size_t)row * 2048 + n0 + col0_) = pack8(v_);
                    float ss = 0.f;
                    _Pragma("unroll") for (int e = 0; e < 8; ++e) ss += v_[e] * v_[e];
                    ss += __shfl_xor(ss, 1); ss += __shfl_xor(ss, 2); ss += __shfl_xor(ss, 4); ss += __shfl_xor(ss, 8);
                    if ((threadIdx.x & 15) == 0) ssq[(size_t)row * 16 + nt] = ss;
                }
                __syncthreads();
            }
        }
    }
}

DEV void phaseI(const Params& P, unsigned char* smem) {
    const int tid = threadIdx.x, lane = tid & 63, wid = tid >> 6;
    unsigned char* ws = P.ws;
    for (int job = blockIdx.x; job < 2048; job += gridDim.x) {
        const int row = job * 4 + wid;
        float sse = (lane < 16) ? ((const float*)(ws + O_SSQE))[(size_t)row * 16 + lane] : 0.f;
        sse = wave_sum(sse);
        const float rinv_e = rsqrtf(sse * (1.f / 2048.f) + 1e-6f);
        float4* xo = (float4*)(P.out + (size_t)row * 2048);
        const uint2* gt = (const uint2*)((const u16*)(ws + O_GS) + (size_t)row * 2048);
        const uint2* er = (const uint2*)((const u16*)(ws + O_GA) + (size_t)row * 2048);
        const float4* gp = (const float4*)P.g_ple_post;
        const float4* gf = (const float4*)P.g_final;
        float4 v[8];
        float ss = 0.f;
#pragma unroll
        for (int i = 0; i < 8; ++i) {
            const int c = lane + 64 * i;
            const float4 x1 = xo[c];
            const uint2 g2 = gt[c], e2 = er[c];
            const float4 gg = gp[c];
            float4 o;
            o.x = x1.x + __uint_as_float(g2.x << 16) * (__uint_as_float(e2.x << 16) * rinv_e * gg.x);
            o.y = x1.y + __uint_as_float(g2.x & 0xFFFF0000u) * (__uint_as_float(e2.x & 0xFFFF0000u) * rinv_e * gg.y);
            o.z = x1.z + __uint_as_float(g2.y << 16) * (__uint_as_float(e2.y << 16) * rinv_e * gg.z);
            o.w = x1.w + __uint_as_float(g2.y & 0xFFFF0000u) * (__uint_as_float(e2.y & 0xFFFF0000u) * rinv_e * gg.w);
            v[i] = o;
            ss += o.x * o.x + o.y * o.y + o.z * o.z + o.w * o.w;
        }
        ss = wave_sum(ss);
        const float rinv = rsqrtf(ss * (1.f / 2048.f) + 1e-6f);
#pragma unroll
        for (int i = 0; i < 8; ++i) {
            const int c = lane + 64 * i;
            const float4 g = gf[c];
            xo[c] = make_float4(v[i].x * rinv * g.x, v[i].y * rinv * g.y, v[i].z * rinv * g.z, v[i].w * rinv * g.w);
        }
    }
}

#define XB_TMO      128
#define XB_XCNT(j)  (256  + 64 * (j))
#define XB_XSUB(j)  (1280 + 64 * (j))
#define XB_XGEN(j)  (2304 + 64 * (j))
#define XB_TOP      3328
#define XB_TOPGEN   3392
#define XCD_BAR_WORDS 3456
#define XB_SPIN_CAP (1u << 18)
#define LAS __attribute__((address_space(3)))

__device__ __forceinline__ unsigned xb_ld(unsigned* p)              { return __hip_atomic_load(p, __ATOMIC_RELAXED, __HIP_MEMORY_SCOPE_AGENT); }
__device__ __forceinline__ unsigned xb_add(unsigned* p, unsigned v) { return __hip_atomic_fetch_add(p, v, __ATOMIC_RELAXED, __HIP_MEMORY_SCOPE_AGENT); }
__device__ __forceinline__ unsigned xb_xcc_id() { return (unsigned)__builtin_amdgcn_s_getreg((3 << 11) | 20) & 0xFu; }
#define XB_SPIN(cond, bar) do { unsigned _sp = 0; while (cond) { __builtin_amdgcn_s_sleep(1); \
    if ((++_sp & 255u) == 0u) { if (xb_ld(&(bar)[XB_TMO])) break; if (_sp > XB_SPIN_CAP) { atomicAdd(&(bar)[XB_TMO], 1u); break; } } } } while (0)

struct XcdBarrier {
    unsigned* bar; unsigned x;
    volatile LAS unsigned* st;
};

__device__ __forceinline__ XcdBarrier xcd_barrier_post(unsigned* bar, volatile LAS unsigned* st) {
    XcdBarrier b; b.bar = bar; b.x = xb_xcc_id(); b.st = st;
    if (threadIdx.x == 0) (void)xb_add(&bar[XB_XCNT(b.x)], 1u);
    return b;
}
__device__ __forceinline__ void xcd_barrier_complete(unsigned* bar, unsigned x, unsigned& nloc, unsigned& nx) {
    const unsigned G = gridDim.x * gridDim.y * gridDim.z;
    unsigned sum, cnt, mine, sp = 0u;
    for (;;) {
        sum = 0u; cnt = 0u; mine = 0u;
#pragma unroll
        for (unsigned j = 0; j < 16; ++j) { const unsigned c = xb_ld(&bar[XB_XCNT(j)]); sum += c; cnt += (c > 0u) ? 1u : 0u; mine = (j == x) ? c : mine; }
        if (sum == G) break;
        __builtin_amdgcn_s_sleep(1);
        if ((++sp & 255u) == 0u) { if (xb_ld(&bar[XB_TMO])) break; if (sp > XB_SPIN_CAP) { atomicAdd(&bar[XB_TMO], 1u); break; } }
    }
    nloc = mine > 0u ? mine : 1u; nx = cnt > 0u ? cnt : 1u;
}

__device__ __forceinline__ void xcd_barrier(const XcdBarrier& b) {
    asm volatile("s_waitcnt vmcnt(0)" ::: "memory");
    __syncthreads();
    if (threadIdx.x == 0) {
        unsigned* bar = b.bar;
        __builtin_amdgcn_s_waitcnt(0);
        unsigned nloc = b.st[0], nx = b.st[1];
        if (nloc == 0u) { xcd_barrier_complete(bar, b.x, nloc, nx); b.st[0] = nloc; b.st[1] = nx; }
        const unsigned old = xb_add(&bar[XB_XSUB(b.x)], 1u);
        const unsigned gen = old / nloc;
        if (old + 1u == (gen + 1u) * nloc) {
            __builtin_amdgcn_fence(__ATOMIC_RELEASE, "agent");
            asm volatile("s_waitcnt vmcnt(0)" ::: "memory");
            const unsigned og = xb_add(&bar[XB_TOP], 1u);
            const unsigned tg = og / nx;
            if (og + 1u == (tg + 1u) * nx) xb_add(&bar[XB_TOPGEN], 1u);
            else XB_SPIN(xb_ld(&bar[XB_TOPGEN]) == tg, bar);
            __builtin_amdgcn_fence(__ATOMIC_ACQUIRE, "agent");
            xb_add(&bar[XB_XGEN(b.x)], 1u);
            asm volatile("s_waitcnt vmcnt(0)" ::: "memory");
        } else {
            XB_SPIN(xb_ld(&bar[XB_XGEN(b.x)]) == gen, bar);
            __builtin_amdgcn_fence(__ATOMIC_ACQUIRE, "agent");
            asm volatile("s_waitcnt vmcnt(0)" ::: "memory");
        }
    }
    __syncthreads();
}


__global__ void __launch_bounds__(256, 2) mega(Params P) {
    extern __shared__ __align__(16) unsigned char smem[];
    cg::grid_group grid = cg::this_grid();
    const int lo = P.ph_lo, hi = P.ph_hi;
    volatile LAS unsigned* xst = (volatile LAS unsigned*)(smem + LDS_BYTES - 16);
    if (threadIdx.x == 0) { xst[0] = 0u; xst[1] = 0u; }
    __syncthreads();
    const XcdBarrier xb = xcd_barrier_post((unsigned*)(P.ws + O_BAR), xst);
    if (lo < 0) grid.sync();
    if (lo <= 0 && 0 < hi) phaseA(P, smem);
#if PROBE_DUP == 0
    xcd_barrier(xb); phaseA(P, smem);
#endif
    if (lo < 1 && 1 < hi) xcd_barrier(xb);
    if (lo <= 1 && 1 < hi) phaseB(P, smem);
#if PROBE_DUP == 1
    xcd_barrier(xb); phaseB(P, smem);
#endif
    if (lo < 2 && 2 < hi) xcd_barrier(xb);
    if (lo <= 2 && 2 < hi) phaseC(P, smem);
#if PROBE_DUP == 2
    xcd_barrier(xb); phaseC(P, smem);
#endif
    if (lo < 3 && 3 < hi) xcd_barrier(xb);
    if (lo <= 3 && 3 < hi) phaseD(P, smem);
#if PROBE_DUP == 3
    xcd_barrier(xb); phaseD(P, smem);
#endif
    if (lo < 4 && 4 < hi) xcd_barrier(xb);
    if (lo <= 4 && 4 < hi) phaseE(P, smem);
#if PROBE_DUP == 4
    xcd_barrier(xb); phaseE(P, smem);
#endif
    if (lo < 5 && 5 < hi) xcd_barrier(xb);
    if (lo <= 5 && 5 < hi) phaseF(P, smem);
#if PROBE_DUP == 5
    xcd_barrier(xb); phaseF(P, smem);
#endif
    if (lo < 6 && 6 < hi) xcd_barrier(xb);
    if (lo <= 6 && 6 < hi) phaseG(P, smem);
#if PROBE_DUP == 6
    xcd_barrier(xb); phaseG(P, smem);
#endif
    if (lo < 7 && 7 < hi) xcd_barrier(xb);
    if (lo <= 7 && 7 < hi) phaseH(P, smem);
#if PROBE_DUP == 7
    xcd_barrier(xb); phaseH(P, smem);
#endif
    if (lo < 8 && 8 < hi) xcd_barrier(xb);
    if (lo <= 8 && 8 < hi) phaseI(P, smem);
}

extern "C" void kernel_launch(void* const* d_in, const int* in_sizes, int n_in, void* d_out, int out_size,
                              void* d_ws, size_t ws_size, hipStream_t stream) {
    static int grid_blocks = 0;
    if (!grid_blocks) {
        if (n_in != 25 || ws_size < WS_END) { fprintf(stderr, "kernel_launch: unexpected n_in %d / ws %zu (need %zu)\n", n_in, ws_size, (size_t)WS_END); grid_blocks = -1; return; }
        int dev = 0, cus = 0, per_cu = 0;
        hipGetDevice(&dev);
        hipDeviceGetAttribute(&cus, hipDeviceAttributeMultiprocessorCount, dev);
        hipFuncSetAttribute((const void*)mega, hipFuncAttributeMaxDynamicSharedMemorySize, LDS_BYTES);
        hipOccupancyMaxActiveBlocksPerMultiprocessor(&per_cu, (const void*)mega, 256, LDS_BYTES);
        if (per_cu < 1) per_cu = 1;
        if (per_cu > 2) per_cu = 2;
        grid_blocks = cus * per_cu;
    }
    if (grid_blocks < 0) return;
    Params p{};
    const float** f = (const float**)&p;
    for (int i = 0; i < 25; ++i) f[i] = (const float*)d_in[i];
    p.out = (float*)d_out;
    p.ws = (unsigned char*)d_ws;
    (void)hipMemsetAsync((unsigned char*)d_ws + O_BAR, 0, XCD_BAR_WORDS * sizeof(unsigned), stream);
#if N_LAUNCH_MODE == 1
    p.ph_lo = 0; p.ph_hi = NPHASE;
    void* args[] = {&p};
    hipError_t e = hipLaunchCooperativeKernel((const void*)mega, dim3(grid_blocks), dim3(256), args, LDS_BYTES, stream);
    if (e != hipSuccess) fprintf(stderr, "cooperative launch failed: %s (grid %d)\n", hipGetErrorString(e), grid_blocks);
#else
    for (int ph = 0; ph < NPHASE; ++ph) {
        p.ph_lo = ph; p.ph_hi = ph + 1;
        hipLaunchKernelGGL(mega, dim3(grid_blocks), dim3(256), LDS_BYTES, stream, p);
    }
#endif
}
```

```cpp
#include <hip/hip_runtime.h>
#include <hip/hip_cooperative_groups.h>
#include <stdint.h>
#include <stdio.h>
namespace cg = cooperative_groups;

#ifndef PROBE_DUP
#define PROBE_DUP -1
#endif
#ifndef PROBE_SEC
#define PROBE_SEC 0
#endif
#ifndef N_LAUNCH_MODE
#define N_LAUNCH_MODE 1
#endif

typedef unsigned short u16;
typedef short bf16x8 __attribute__((ext_vector_type(8)));
typedef float f32x16 __attribute__((ext_vector_type(16)));
typedef float f32x4 __attribute__((ext_vector_type(4)));

#define DEV __device__ __forceinline__
#define LDS_FENCE() asm volatile("s_waitcnt lgkmcnt(0)" ::: "memory")

constexpr int NPHASE = 9;
constexpr int LDS_BYTES = 70656;

constexpr size_t O_WIN = 0;
constexpr size_t O_YACT = 0;
constexpr size_t O_YATT = 16777216;
constexpr size_t O_WUQ = 34078720;
constexpr size_t O_WGLU = O_WUQ + 2097152;
constexpr size_t O_WSSMO = O_WGLU + 4194304;
constexpr size_t O_WATTO = O_WSSMO + 4194304;
constexpr size_t O_WO = O_WATTO + 4194304;
constexpr size_t O_WPG = O_WO + 8388608;
constexpr size_t O_WPLE = O_WPG + 8388608;
constexpr size_t O_H = O_WPLE + 1048576;
constexpr size_t O_Q = O_H;
constexpr size_t O_QIDX = O_H + 16777216;
constexpr size_t O_MERGED = O_H;
constexpr size_t O_U = O_H + 33554432;
constexpr size_t O_ZS = O_U + 16777216;
constexpr size_t O_X1B = O_U;
constexpr size_t O_CQ = O_ZS + 16777216;
constexpr size_t O_K = O_CQ + 8388608;
constexpr size_t O_V = O_K + 4194304;
constexpr size_t O_ZA = O_V + 4194304;
constexpr size_t O_GS = O_ZA + 16777216;
constexpr size_t O_GA = O_GS + 33554432;
constexpr size_t O_KIDXRAW = O_GA + 33554432;
constexpr size_t O_KIDX = O_KIDXRAW + 2097152;
constexpr size_t O_WIDX = O_KIDX + 1048576;
constexpr size_t O_PBF = O_WIDX + 524288;
constexpr size_t O_ABAR = O_PBF + 4194304;
constexpr size_t O_ABART = O_ABAR + 32768;
constexpr size_t O_BBT = O_ABART + 32768;
constexpr size_t O_CCT = O_BBT + 262144;
constexpr size_t O_ENDST = O_CCT + 524288;
constexpr size_t O_SSQ1 = O_ENDST + 1048576;
constexpr size_t O_SSQE = O_SSQ1 + 1048576;
constexpr size_t O_SSQC = O_SSQE + 1048576;
constexpr size_t O_BAR = O_SSQC + 131072;
constexpr size_t WS_END = O_BAR + 16384;

struct Params {
    const float *x, *p, *g_mix, *w_in, *g_q, *w_uq, *w_uq_idx, *g_kidx, *a_re, *a_im, *log_dt, *b_re, *b_im,
        *c_re, *c_im, *d_skip, *w_glu, *w_ssm_out, *w_attn_out, *w_o, *g_ple, *w_ple_gate, *w_ple, *g_ple_post, *g_final;
    float* out;
    unsigned char* ws;
    int ph_lo, ph_hi;
};

DEV u16 f2bf(float f) { uint32_t u = __float_as_uint(f); u += 0x7FFFu + ((u >> 16) & 1u); return (u16)(u >> 16); }
DEV float bf2f(u16 h) { return __uint_as_float(((uint32_t)h) << 16); }
DEV uint32_t pack2(float a, float b) { return (uint32_t)f2bf(a) | ((uint32_t)f2bf(b) << 16); }
DEV float sigmoidf_(float x) { return 1.f / (1.f + __expf(-x)); }
DEV float siluf_(float x) { return x / (1.f + __expf(-x)); }
DEV float geluf_(float x) { float u = 0.7978845608028654f * (x + 0.044715f * x * x * x); return x - x / (1.f + __expf(2.f * u)); }
DEV float wave_sum(float v) { for (int d = 32; d >= 1; d >>= 1) v += __shfl_xor(v, d); return v; }
#define DPPF_(v, ctrl) __int_as_float(__builtin_amdgcn_mov_dpp(__float_as_int(v), ctrl, 0xF, 0xF, true))
DEV float wave_max_fast(float v) {
    v = fmaxf(v, DPPF_(v, 0xB1)); v = fmaxf(v, DPPF_(v, 0x4E)); v = fmaxf(v, DPPF_(v, 0x141)); v = fmaxf(v, DPPF_(v, 0x140));
    const float r0 = __int_as_float(__builtin_amdgcn_readlane(__float_as_int(v), 0)), r1 = __int_as_float(__builtin_amdgcn_readlane(__float_as_int(v), 16));
    const float r2 = __int_as_float(__builtin_amdgcn_readlane(__float_as_int(v), 32)), r3 = __int_as_float(__builtin_amdgcn_readlane(__float_as_int(v), 48));
    return fmaxf(fmaxf(r0, r1), fmaxf(r2, r3));
}
DEV float wave_sum_fast(float v) {
    v += DPPF_(v, 0xB1); v += DPPF_(v, 0x4E); v += DPPF_(v, 0x141); v += DPPF_(v, 0x140);
    const float r0 = __int_as_float(__builtin_amdgcn_readlane(__float_as_int(v), 0)), r1 = __int_as_float(__builtin_amdgcn_readlane(__float_as_int(v), 16));
    const float r2 = __int_as_float(__builtin_amdgcn_readlane(__float_as_int(v), 32)), r3 = __int_as_float(__builtin_amdgcn_readlane(__float_as_int(v), 48));
    return (r0 + r1) + (r2 + r3);
}
DEV float wave_max(float v) { for (int d = 32; d >= 1; d >>= 1) v = fmaxf(v, __shfl_xor(v, d)); return v; }

DEV void gemm_mainloop(const u16* __restrict__ A, int lda, const u16* __restrict__ B, int ldb, int K,
                       unsigned char* smem, f32x16 (&acc)[2][2]) {
    const int tid = threadIdx.x, lane = tid & 63, wid = tid >> 6;
    const int wm = wid >> 1, wn = wid & 1;
    const int lrow = tid >> 3, lslot = tid & 7;
    uint4 pa0, pa1, pa2, pa3, pb0, pb1, pb2, pb3;
    uint4 qa0, qa1, qa2, qa3, qb0, qb1, qb2, qb3;
    const u16* Ap = A + (size_t)lrow * lda + lslot * 8;
    const u16* Bp = B + (size_t)lrow * ldb + lslot * 8;
    const size_t a32 = (size_t)32 * lda, b32 = (size_t)32 * ldb;
    const int woff = lrow * 128 + ((lslot ^ ((lrow >> 1) & 7)) << 4);
#define GLOAD(S, k0) { S##a0 = *(const uint4*)(Ap + (k0)); S##a1 = *(const uint4*)(Ap + a32 + (k0)); S##a2 = *(const uint4*)(Ap + 2 * a32 + (k0)); S##a3 = *(const uint4*)(Ap + 3 * a32 + (k0)); \
                       S##b0 = *(const uint4*)(Bp + (k0)); S##b1 = *(const uint4*)(Bp + b32 + (k0)); S##b2 = *(const uint4*)(Bp + 2 * b32 + (k0)); S##b3 = *(const uint4*)(Bp + 3 * b32 + (k0)); }
#define SWRITE(S, buf) { unsigned char* as_ = smem + (buf) * 16384 + woff; unsigned char* bs_ = smem + 32768 + (buf) * 16384 + woff; \
                      *(uint4*)(as_) = S##a0; *(uint4*)(as_ + 4096) = S##a1; *(uint4*)(as_ + 8192) = S##a2; *(uint4*)(as_ + 12288) = S##a3; \
                      *(uint4*)(bs_) = S##b0; *(uint4*)(bs_ + 4096) = S##b1; *(uint4*)(bs_ + 8192) = S##b2; *(uint4*)(bs_ + 12288) = S##b3; }
    const int nk = K >> 6;
    const int rA = wm * 64 + (lane & 31), rB = wn * 64 + (lane & 31);
    const int swA = (rA >> 1) & 7, swB = (rB >> 1) & 7;
    const int h = lane >> 5;
#define FRAG(ks, a0, a1, b0, b1) const int slot##ks = (ks) * 2 + h; \
            const bf16x8 a0 = *(const bf16x8*)(as_ + ((slot##ks ^ swA) << 4)); const bf16x8 a1 = *(const bf16x8*)(as_ + 4096 + ((slot##ks ^ swA) << 4)); \
            const bf16x8 b0 = *(const bf16x8*)(bs_ + ((slot##ks ^ swB) << 4)); const bf16x8 b1 = *(const bf16x8*)(bs_ + 4096 + ((slot##ks ^ swB) << 4));
#define MM(a0, a1, b0, b1) acc[0][0] = __builtin_amdgcn_mfma_f32_32x32x16_bf16(a0, b0, acc[0][0], 0, 0, 0); acc[0][1] = __builtin_amdgcn_mfma_f32_32x32x16_bf16(a0, b1, acc[0][1], 0, 0, 0); \
            acc[1][0] = __builtin_amdgcn_mfma_f32_32x32x16_bf16(a1, b0, acc[1][0], 0, 0, 0); acc[1][1] = __builtin_amdgcn_mfma_f32_32x32x16_bf16(a1, b1, acc[1][1], 0, 0, 0);
#define COMPUTE(cur) { const unsigned char* as_ = smem + (cur) * 16384 + rA * 128; const unsigned char* bs_ = smem + 32768 + (cur) * 16384 + rB * 128; \
        FRAG(0, fa00, fa01, fb00, fb01) FRAG(1, fa10, fa11, fb10, fb11) FRAG(2, fa20, fa21, fb20, fb21) FRAG(3, fa30, fa31, fb30, fb31) \
        MM(fa00, fa01, fb00, fb01) MM(fa10, fa11, fb10, fb11) MM(fa20, fa21, fb20, fb21) MM(fa30, fa31, fb30, fb31) \
        __builtin_amdgcn_sched_group_barrier(0x100, 8, 0); __builtin_amdgcn_sched_group_barrier(0x008, 4, 0); \
        __builtin_amdgcn_sched_group_barrier(0x100, 4, 0); __builtin_amdgcn_sched_group_barrier(0x008, 4, 0); \
        __builtin_amdgcn_sched_group_barrier(0x100, 4, 0); __builtin_amdgcn_sched_group_barrier(0x008, 8, 0); }
    GLOAD(p, 0);
    GLOAD(q, 64);
    SWRITE(p, 0);
    __syncthreads();
    for (int kt = 0; kt < nk; kt += 2) {
        if (kt + 2 < nk) GLOAD(p, (kt + 2) * 64);
        COMPUTE(0);
        SWRITE(q, 1);
        __syncthreads();
        if (kt + 3 < nk) GLOAD(q, (kt + 3) * 64);
        COMPUTE(1);
        if (kt + 2 < nk) SWRITE(p, 0);
        __syncthreads();
    }
#undef GLOAD
#undef SWRITE
#undef COMPUTE
#undef FRAG
#undef MM
}

DEV void stage_half(const f32x16 (&acc)[2][2], int mi, float* st) {
    const int lane = threadIdx.x & 63, wid = threadIdx.x >> 6, wm = wid >> 1, wn = wid & 1;
#pragma unroll
    for (int ni = 0; ni < 2; ++ni)
#pragma unroll
        for (int r = 0; r < 16; ++r)
            st[(wm * 32 + (r & 3) + 8 * (r >> 2) + 4 * (lane >> 5)) * 132 + wn * 64 + ni * 32 + (lane & 31)] = mi ? acc[1][ni][r] : acc[0][ni][r];
    __syncthreads();
}
#define SR_TO_ROW(sr, mi) ((((sr) >> 5) << 6) + (mi) * 32 + ((sr) & 31))
typedef unsigned u32x4nt __attribute__((ext_vector_type(4)));
DEV uint4 ld_nt16(const void* p) { const u32x4nt t = __builtin_nontemporal_load((const u32x4nt*)p); return make_uint4(t[0], t[1], t[2], t[3]); }
DEV uint4 pack8(const float (&v)[8]) { uint4 o; o.x = pack2(v[0], v[1]); o.y = pack2(v[2], v[3]); o.z = pack2(v[4], v[5]); o.w = pack2(v[6], v[7]); return o; }
DEV void unpack8(const uint4 q, float (&v)[8]) {
    v[0] = __uint_as_float(q.x << 16); v[1] = __uint_as_float(q.x & 0xFFFF0000u); v[2] = __uint_as_float(q.y << 16); v[3] = __uint_as_float(q.y & 0xFFFF0000u);
    v[4] = __uint_as_float(q.z << 16); v[5] = __uint_as_float(q.z & 0xFFFF0000u); v[6] = __uint_as_float(q.w << 16); v[7] = __uint_as_float(q.w & 0xFFFF0000u);
}
#define FOR_CHUNKS(st) _Pragma("unroll") for (int i_ = 0; i_ < 4; ++i_)
#define CHUNK_LOAD(st) const int cid_ = threadIdx.x + 256 * i_; const int sr_ = cid_ >> 4, col0_ = (cid_ & 15) * 8; float v_[8]; \
    { const float4 x0_ = *(const float4*)((st) + sr_ * 132 + col0_), x1_ = *(const float4*)((st) + sr_ * 132 + col0_ + 4); \
      v_[0] = x0_.x; v_[1] = x0_.y; v_[2] = x0_.z; v_[3] = x0_.w; v_[4] = x1_.x; v_[5] = x1_.y; v_[6] = x1_.z; v_[7] = x1_.w; }

DEV int cbar_() { asm volatile("" ::: "memory"); return 0; }
#define ZERO_ACC(acc) { _Pragma("unroll") for (int i_ = 0; i_ < 2; ++i_) _Pragma("unroll") for (int j_ = 0; j_ < 2; ++j_) _Pragma("unroll") for (int r_ = 0; r_ < 16; ++r_) acc[i_][j_][r_] = 0.f; }
#define FOR_ACC _Pragma("unroll") for (int mi = 0; mi < 2; ++mi) _Pragma("unroll") for (int ni = 0; ni < 2; ++ni) _Pragma("unroll") for (int r = cbar_(); r < 16; ++r)
#define ACC_ROW (wm_ * 64 + mi * 32 + (r & 3) + 8 * (r >> 2) + 4 * (lane_ >> 5))
#define ACC_COL (wn_ * 64 + ni * 32 + (lane_ & 31))
#define ACC_IDS const int lane_ = threadIdx.x & 63, wm_ = (threadIdx.x >> 6) >> 1, wn_ = (threadIdx.x >> 6) & 1;

struct WcJob { const float* src; const float* ksc; u16* dst; int ld, c0, c1, nvalid, K, k0; };
DEV WcJob wconv_decode(const Params& P, int job) {
    unsigned char* ws = P.ws;
    const float* src; const float* ksc = nullptr; u16* dst; int ld, c0, c1, nvalid = 64, K, kt, n0;
    if (job < 2080) {
        n0 = (job >> 4) * 64; kt = job & 15; K = 2048; src = P.w_in; ld = 8272;
        if (n0 < 4096) c0 = n0; else if (n0 < 8192) c0 = n0 + 80; else { c0 = n0 - 8192 + 4096; nvalid = min(64, max(0, 8272 - n0)); }
        c1 = c0 + 32;
        dst = (u16*)(ws + O_WIN) + (size_t)n0 * 2048;
    } else if (job < 2208) {
        const int lt = job - 2080; n0 = (lt >> 2) * 64; kt = lt & 3; K = 512; ld = 1024; ksc = P.g_q;
        if (n0 < 1024) { src = P.w_uq; c0 = n0; } else { src = P.w_uq_idx; c0 = n0 - 1024; }
        c1 = c0 + 32;
        dst = (u16*)(ws + O_WUQ) + (size_t)n0 * 512;
    } else if (job < 2464) {
        const int lt = job - 2208; n0 = (lt >> 3) * 64; kt = lt & 7; K = 1024; ld = 2048; src = P.w_glu;
        c0 = (n0 >> 6) * 32; c1 = 1024 + c0;
        dst = (u16*)(ws + O_WGLU) + (size_t)n0 * 1024;
    } else if (job < 2720) {
        const int lt = job - 2464; n0 = (lt >> 3) * 64; kt = lt & 7; K = 1024; ld = 2048; src = P.w_ssm_out; c0 = n0; c1 = c0 + 32;
        dst = (u16*)(ws + O_WSSMO) + (size_t)n0 * 1024;
    } else if (job < 2976) {
        const int lt = job - 2720; n0 = (lt >> 3) * 64; kt = lt & 7; K = 1024; ld = 2048; src = P.w_attn_out; c0 = n0; c1 = c0 + 32;
        dst = (u16*)(ws + O_WATTO) + (size_t)n0 * 1024;
    } else if (job < 3488) {
        const int lt = job - 2976; n0 = (lt >> 4) * 64; kt = lt & 15; K = 2048; ld = 2048; src = P.w_o; c0 = n0; c1 = c0 + 32;
        dst = (u16*)(ws + O_WO) + (size_t)n0 * 2048;
    } else if (job < 4000) {
        const int lt = job - 3488; n0 = (lt >> 4) * 64; kt = lt & 15; K = 2048; ld = 2048; src = P.w_ple_gate; c0 = n0; c1 = c0 + 32; ksc = P.g_ple;
        dst = (u16*)(ws + O_WPG) + (size_t)n0 * 2048;
    } else {
        const int lt = job - 4000; n0 = (lt >> 1) * 64; kt = lt & 1; K = 256; ld = 2048; src = P.w_ple; c0 = n0; c1 = c0 + 32;
        dst = (u16*)(ws + O_WPLE) + (size_t)n0 * 256;
    }
    WcJob j; j.src = src; j.ksc = ksc; j.dst = dst; j.ld = ld; j.c0 = c0; j.c1 = c1; j.nvalid = nvalid; j.K = K; j.k0 = kt * 128;
    return j;
}
DEV void wconv_load(const WcJob& j, float4 (&v)[8]) {
    const int tid = threadIdx.x;
    const int c = (tid & 15) * 4;
    const int sc = (c < 32) ? (j.c0 + c) : (j.c1 + c - 32);
#pragma unroll
    for (int it = 0; it < 8; ++it) {
        const int kr = it * 16 + (tid >> 4);
        v[it] = make_float4(0.f, 0.f, 0.f, 0.f);
        if (c < j.nvalid) v[it] = *(const float4*)(j.src + (size_t)(j.k0 + kr) * j.ld + sc);
    }
}
DEV void wconv_finish(const WcJob& j, const float4 (&v)[8], u16* tile) {
    const int tid = threadIdx.x;
    const int c = (tid & 15) * 4;
#pragma unroll
    for (int it = 0; it < 8; ++it) {
        const int kr = it * 16 + (tid >> 4);
        const float f = j.ksc ? j.ksc[j.k0 + kr] : 1.f;
        uint2 o; o.x = pack2(v[it].x * f, v[it].y * f); o.y = pack2(v[it].z * f, v[it].w * f);
        *(uint2*)(tile + kr * 68 + c) = o;
    }
    __syncthreads();
    const int n = tid & 63, kq = (tid >> 6) * 32;
    u16* dp = j.dst + (size_t)n * j.K + j.k0 + kq;
#pragma unroll
    for (int h = 0; h < 4; ++h) {
        uint32_t w[4];
#pragma unroll
        for (int e = 0; e < 4; ++e) w[e] = (uint32_t)tile[(kq + h * 8 + 2 * e) * 68 + n] | ((uint32_t)tile[(kq + h * 8 + 2 * e + 1) * 68 + n] << 16);
        *(uint4*)(dp + h * 8) = make_uint4(w[0], w[1], w[2], w[3]);
    }
    __syncthreads();
}
DEV void wconv_run(const Params& P, int first, int end, int stride, u16* tile) {
    if (first >= end) return;
    float4 va[8], vb[8];
    wconv_load(wconv_decode(P, first), va);
    for (int job = first; job < end; job += 2 * stride) {
        if (job + stride < end) wconv_load(wconv_decode(P, job + stride), vb);
        wconv_finish(wconv_decode(P, job), va, tile);
        if (job + stride < end) {
            if (job + 2 * stride < end) wconv_load(wconv_decode(P, job + 2 * stride), va);
            wconv_finish(wconv_decode(P, job + stride), vb, tile);
        }
    }
}

DEV void phaseA(const Params& P, unsigned char* smem) {
    const int tid = threadIdx.x, lane = tid & 63, wid = tid >> 6;
    const int nb = gridDim.x;
    unsigned char* ws = P.ws;
    wconv_run(P, blockIdx.x, 2208, nb, (u16*)smem);
    for (int job = blockIdx.x; job < 2048; job += nb) {
        const int row = job * 4 + wid;
        const float4* xr = (const float4*)(P.x + (size_t)row * 2048);
        const float4* gr = (const float4*)P.g_mix;
        float4 v[8];
        float ss = 0.f;
#pragma unroll
        for (int i = 0; i < 8; ++i) { typedef float f32x4n_ __attribute__((ext_vector_type(4))); const f32x4n_ t_ = __builtin_nontemporal_load((const f32x4n_*)(xr + lane + 64 * i)); v[i] = make_float4(t_[0], t_[1], t_[2], t_[3]); ss += v[i].x * v[i].x + v[i].y * v[i].y + v[i].z * v[i].z + v[i].w * v[i].w; }
        ss = wave_sum(ss);
        const float rinv = rsqrtf(ss * (1.f / 2048.f) + 1e-6f);
        u16* hr = (u16*)(ws + O_H) + (size_t)row * 2048;
#pragma unroll
        for (int i = 0; i < 8; ++i) {
            const float4 g = gr[lane + 64 * i];
            uint2 o; o.x = pack2(v[i].x * rinv * g.x, v[i].y * rinv * g.y); o.y = pack2(v[i].z * rinv * g.z, v[i].w * rinv * g.w);
            *(uint2*)(hr + (lane + 64 * i) * 4) = o;
        }
    }
    for (int job = blockIdx.x; job < 16; job += nb) {
        const int gn = job * 256 + tid, g = gn >> 6, n = gn & 63;
        const float dt = expf(P.log_dt[g]);
        const float ar = P.a_re[gn], ai = P.a_im[gn];
        const float mag = expf(dt * ar);
        const float abr = mag * cosf(dt * ai), abi = mag * sinf(dt * ai);
        const float den = ar * ar + ai * ai, nr = abr - 1.f;
        const float fr = (nr * ar + abi * ai) / den, fi = (abi * ar - nr * ai) / den;
        ((float2*)(ws + O_ABAR))[gn] = make_float2(abr, abi);
        float pr = abr, pi = abi;
#pragma unroll
        for (int s = 0; s < 8; ++s) { const float t = pr * pr - pi * pi; pi = 2.f * pr * pi; pr = t; }
        ((float2*)(ws + O_ABART))[gn] = make_float2(pr, pi);
        const int rc = (n >> 5) * 64 + (n & 31), ic = rc + 32;
        u16* bbt = (u16*)(ws + O_BBT) + (size_t)g * 128 * 16;
        u16* cct = (u16*)(ws + O_CCT) + (size_t)g * 32 * 128;
        for (int c = 0; c < 16; ++c) {
            const float br = P.b_re[gn * 16 + c], bi = P.b_im[gn * 16 + c];
            bbt[rc * 16 + c] = f2bf(fr * br - fi * bi);
            bbt[ic * 16 + c] = f2bf(fr * bi + fi * br);
            cct[c * 128 + rc] = f2bf(P.c_re[(g * 16 + c) * 64 + n]);
            cct[c * 128 + ic] = f2bf(-P.c_im[(g * 16 + c) * 64 + n]);
            cct[(16 + c) * 128 + rc] = 0;
            cct[(16 + c) * 128 + ic] = 0;
        }
    }
}

DEV void phaseB(const Params& P, unsigned char* smem) {
    ACC_IDS
    unsigned char* ws = P.ws;
    for (int job = blockIdx.x; job < 4160 + 1856 + 1024; job += gridDim.x) {
        if (job >= 4160) {
            if (job < 4160 + 1856) { const WcJob wj = wconv_decode(P, job - 4160 + 2208); float4 vv[8]; wconv_load(wj, vv); wconv_finish(wj, vv, (u16*)smem); }
            else {
                const size_t e0 = (size_t)(job - 4160 - 1856) * 2048 + threadIdx.x * 8;
                const float4 a = *(const float4*)(P.p + e0), b = *(const float4*)(P.p + e0 + 4);
                uint4 o; o.x = pack2(a.x, a.y); o.y = pack2(a.z, a.w); o.z = pack2(b.x, b.y); o.w = pack2(b.z, b.w);
                *(uint4*)((u16*)(ws + O_PBF) + e0) = o;
            }
            continue;
        }
        const int mt = job & 63, nt = job >> 6;
        f32x16 acc[2][2];
        ZERO_ACC(acc);
        gemm_mainloop((const u16*)(ws + O_H) + (size_t)mt * 128 * 2048, 2048, (const u16*)(ws + O_WIN) + (size_t)nt * 128 * 2048, 2048, 2048, smem, acc);
        const int m0 = mt * 128;
        float* st = (float*)smem;
        u16* dst = nullptr; int ld = 0, cofs = 0, act = 0;
        if (nt < 8) { dst = (u16*)(ws + O_U); ld = 1024; cofs = nt * 128; }
        else if (nt < 16) { dst = (u16*)(ws + O_ZS); ld = 1024; cofs = (nt - 8) * 128; act = 1; }
        else if (nt < 20) { dst = (u16*)(ws + O_CQ); ld = 512; cofs = (nt - 16) * 128; }
        else if (nt < 22) { dst = (u16*)(ws + O_K); ld = 256; cofs = (nt - 20) * 128; }
        else if (nt < 24) { dst = (u16*)(ws + O_V); ld = 256; cofs = (nt - 22) * 128; }
        else if (nt < 32) { dst = (u16*)(ws + O_ZA); ld = 1024; cofs = (nt - 24) * 128; act = 1; }
        else if (nt < 48) { dst = (u16*)(ws + O_GS); ld = 2048; cofs = (nt - 32) * 128; act = 2; }
        else if (nt < 64) { dst = (u16*)(ws + O_GA); ld = 2048; cofs = (nt - 48) * 128; act = 2; }
#pragma unroll 1
        for (int mi = 0; mi < 2; ++mi) {
            stage_half(acc, mi, st);
            FOR_CHUNKS(st) {
                CHUNK_LOAD(st)
                const int row = m0 + SR_TO_ROW(sr_, mi);
                if (nt < 64) {
                    if (act == 1) { _Pragma("unroll") for (int e = 0; e < 8; ++e) v_[e] = siluf_(v_[e]); }
                    else if (act == 2) { _Pragma("unroll") for (int e = 0; e < 8; ++e) v_[e] = sigmoidf_(v_[e]); }
                    *(uint4*)(dst + (size_t)row * ld + cofs + col0_) = pack8(v_);
                    if (nt >= 16 && nt < 20) {
                        float ss = 0.f;
                        _Pragma("unroll") for (int e = 0; e < 8; ++e) ss += v_[e] * v_[e];
                        ss += __shfl_xor(ss, 1); ss += __shfl_xor(ss, 2); ss += __shfl_xor(ss, 4); ss += __shfl_xor(ss, 8);
                        if ((threadIdx.x & 15) == 0) ((float*)(ws + O_SSQC))[(size_t)row * 4 + (nt - 16)] = ss;
                    }
                } else if (col0_ < 64) {
                    float* kr = (float*)(ws + O_KIDXRAW) + (size_t)row * 64 + col0_;
                    *(float4*)kr = make_float4(v_[0], v_[1], v_[2], v_[3]);
                    *(float4*)(kr + 4) = make_float4(v_[4], v_[5], v_[6], v_[7]);
                } else if (col0_ < 80) {
                    float* wr = (float*)(ws + O_WIDX) + (size_t)row * 16 + (col0_ - 64);
                    const float sc = 1.f / 32.f;
                    *(float4*)wr = make_float4(v_[0] * sc, v_[1] * sc, v_[2] * sc, v_[3] * sc);
                    *(float4*)(wr + 4) = make_float4(v_[4] * sc, v_[5] * sc, v_[6] * sc, v_[7] * sc);
                }
            }
            __syncthreads();
        }
    }
}

template <bool PASS2>
DEV void s5_unit(const Params& P, int g, int c, unsigned char* wsm) {
    const int lane = threadIdx.x & 63;
    const int l31 = lane & 31, hl = lane >> 5;
    unsigned char* ws = P.ws;
    float* bu = (float*)wsm;
    const u16* U = (const u16*)(ws + O_U);
    const u16* bbt = (const u16*)(ws + O_BBT) + (size_t)g * 128 * 16;
    bf16x8 bb0 = *(const bf16x8*)(bbt + (0 * 32 + l31) * 16 + 8 * hl);
    bf16x8 bb1 = *(const bf16x8*)(bbt + (1 * 32 + l31) * 16 + 8 * hl);
    bf16x8 bb2 = *(const bf16x8*)(bbt + (2 * 32 + l31) * 16 + 8 * hl);
    bf16x8 bb3 = *(const bf16x8*)(bbt + (3 * 32 + l31) * 16 + 8 * hl);
    const float2 ab = ((const float2*)(ws + O_ABAR))[g * 64 + lane];
    const int rc = (lane >> 5) * 64 + l31, ic = rc + 32;
    bf16x8 cfr[8];
    bf16x8 dfr = {0, 0, 0, 0, 0, 0, 0, 0};
    if (PASS2) {
        const short dbf = (short)f2bf(P.d_skip[g * 16 + (l31 & 15)]);
#pragma unroll
        for (int j = 0; j < 8; ++j) dfr[j] = (l31 == 8 * hl + j) ? dbf : (short)0;
    }
    if (PASS2) {
        const u16* cct = (const u16*)(ws + O_CCT) + (size_t)g * 32 * 128;
#pragma unroll
        for (int ks = 0; ks < 8; ++ks) cfr[ks] = *(const bf16x8*)(cct + l31 * 128 + ks * 16 + 8 * hl);
    }
    float hr = 0.f, hi = 0.f;
    if (PASS2) {
        const float2 abT = ((const float2*)(ws + O_ABART))[g * 64 + lane];
        const float2* E = (const float2*)(ws + O_ENDST);
        for (int cc = 0; cc < c; ++cc) {
            const float2 e = E[((size_t)cc * 64 + g) * 64 + lane];
            const float t = abT.x * hr - abT.y * hi + e.x;
            hi = abT.x * hi + abT.y * hr + e.y;
            hr = t;
        }
    }
    bf16x8 ua_next = __builtin_nontemporal_load((const bf16x8*)(U + (size_t)(c * 256 + l31) * 1024 + g * 16 + 8 * hl));
    for (int st = 0; st < 8; ++st) {
        const int t0 = c * 256 + st * 32;
        const bf16x8 ua = ua_next;
        if (st + 1 < 8) ua_next = __builtin_nontemporal_load((const bf16x8*)(U + (size_t)(t0 + 32 + l31) * 1024 + g * 16 + 8 * hl));
        f32x16 z;
#pragma unroll
        for (int r = 0; r < 16; ++r) z[r] = 0.f;
        f32x16 c0 = __builtin_amdgcn_mfma_f32_32x32x16_bf16(ua, bb0, z, 0, 0, 0);
        f32x16 c1 = __builtin_amdgcn_mfma_f32_32x32x16_bf16(ua, bb1, z, 0, 0, 0);
        f32x16 c2 = __builtin_amdgcn_mfma_f32_32x32x16_bf16(ua, bb2, z, 0, 0, 0);
        f32x16 c3 = __builtin_amdgcn_mfma_f32_32x32x16_bf16(ua, bb3, z, 0, 0, 0);
        LDS_FENCE();
#pragma unroll
        for (int r = 0; r < 16; ++r) {
            const int row = (r & 3) + 8 * (r >> 2) + 4 * hl;
            bu[row * 132 + l31] = c0[r];
            bu[row * 132 + 32 + l31] = c1[r];
            bu[row * 132 + 64 + l31] = c2[r];
            bu[row * 132 + 96 + l31] = c3[r];
        }
        LDS_FENCE();
#pragma unroll
        for (int hb = 0; hb < 2; ++hb) {
            float vr[16], vi[16];
#pragma unroll
            for (int r = 0; r < 16; ++r) { vr[r] = bu[(hb * 16 + r) * 132 + rc]; vi[r] = bu[(hb * 16 + r) * 132 + ic]; }
            LDS_FENCE();
#pragma unroll
            for (int r = 0; r < 16; ++r) {
                const float t = ab.x * hr - ab.y * hi + vr[r];
                hi = ab.x * hi + ab.y * hr + vi[r];
                hr = t;
                if (PASS2) {
                    u16* hrow = (u16*)(bu + (hb * 16 + r) * 132);
                    hrow[rc] = f2bf(hr);
                    hrow[ic] = f2bf(hi);
                }
            }
        }
        if (PASS2) {
            LDS_FENCE();
            f32x16 y;
#pragma unroll
            for (int r = 0; r < 16; ++r) y[r] = 0.f;
#pragma unroll
            for (int ks = 0; ks < 8; ++ks) {
                const bf16x8 ha = *(const bf16x8*)((const unsigned char*)bu + l31 * 528 + (ks * 16 + 8 * hl) * 2);
                y = __builtin_amdgcn_mfma_f32_32x32x16_bf16(ha, cfr[ks], y, 0, 0, 0);
            }
            y = __builtin_amdgcn_mfma_f32_32x32x16_bf16(ua, dfr, y, 0, 0, 0);
            if (l31 < 16) {
#pragma unroll
                for (int r = 0; r < 16; ++r) {
                    const int tl = (r & 3) + 8 * (r >> 2) + 4 * hl;
                    ((u16*)((unsigned char*)bu + tl * 528 + 256))[l31] = f2bf(geluf_(y[r]));
                }
            }
            LDS_FENCE();
            if (lane < 32) {
                const uint4 y0 = *(const uint4*)((const unsigned char*)bu + lane * 528 + 256), y1 = *(const uint4*)((const unsigned char*)bu + lane * 528 + 272);
                u16* yp = (u16*)(ws + O_YACT) + (size_t)(t0 + lane) * 1024 + g * 16;
                typedef unsigned u32x4n __attribute__((ext_vector_type(4))); const u32x4n n0_ = {y0.x, y0.y, y0.z, y0.w}, n1_ = {y1.x, y1.y, y1.z, y1.w};
                __builtin_nontemporal_store(n0_, (u32x4n*)yp); __builtin_nontemporal_store(n1_, (u32x4n*)(yp + 8));
            }
            LDS_FENCE();
        }
    }
    if (!PASS2) ((float2*)(ws + O_ENDST))[((size_t)c * 64 + g) * 64 + lane] = make_float2(hr, hi);
}

DEV void phaseC(const Params& P, unsigned char* smem) {
    ACC_IDS
    const int tid = threadIdx.x, wid = tid >> 6;
    unsigned char* ws = P.ws;
    float* rinv_s = (float*)(smem + 65536);
    for (int job = blockIdx.x; job < 1024 + 32 + 512; job += gridDim.x) {
        if (job < 1024) {
            const int mt = job & 63, nt = job >> 6, m0 = mt * 128;
            const u16* cq = (const u16*)(ws + O_CQ);
            if (tid < 128) {
                const float4 q = *(const float4*)((const float*)(ws + O_SSQC) + (size_t)(m0 + tid) * 4);
                rinv_s[tid] = rsqrtf((q.x + q.y + q.z + q.w) * (1.f / 512.f) + 1e-6f);
            }
            f32x16 acc[2][2];
            ZERO_ACC(acc);
            gemm_mainloop(cq + (size_t)m0 * 512, 512, (const u16*)(ws + O_WUQ) + (size_t)nt * 128 * 512, 512, 512, smem, acc);
            u16* dst = (u16*)(ws + (nt < 8 ? O_Q : O_QIDX));
            const int cofs = (nt & 7) * 128;
            float* st = (float*)smem;
#pragma unroll 1
            for (int mi = 0; mi < 2; ++mi) {
                stage_half(acc, mi, st);
                FOR_CHUNKS(st) {
                    CHUNK_LOAD(st)
                    const int rl = SR_TO_ROW(sr_, mi);
                    const float ri = rinv_s[rl];
                    _Pragma("unroll") for (int e = 0; e < 8; ++e) v_[e] *= ri;
                    { const uint4 pk_ = pack8(v_); const u32x4nt t_ = {pk_.x, pk_.y, pk_.z, pk_.w}; __builtin_nontemporal_store(t_, (u32x4nt*)(dst + (size_t)(m0 + rl) * 1024 + cofs + col0_)); }
                }
                __syncthreads();
            }
        } else if (job < 1056) {
            const int row = (job - 1024) * 256 + tid;
            const float4* kr = (const float4*)((const float*)(ws + O_KIDXRAW) + (size_t)row * 64);
            float4 v[16];
            float ss = 0.f;
#pragma unroll
            for (int i = 0; i < 16; ++i) { v[i] = kr[i]; ss += v[i].x * v[i].x + v[i].y * v[i].y + v[i].z * v[i].z + v[i].w * v[i].w; }
            const float rinv = rsqrtf(ss * (1.f / 64.f) + 1e-6f);
            const float4* gk = (const float4*)P.g_kidx;
            u16* o = (u16*)(ws + O_KIDX) + (size_t)(row >> 5) * 2048 + (row & 31) * 8;
#pragma unroll
            for (int i = 0; i < 16; ++i) {
                const float4 g = gk[i];
                uint2 w; w.x = pack2(v[i].x * rinv * g.x, v[i].y * rinv * g.y); w.y = pack2(v[i].z * rinv * g.z, v[i].w * rinv * g.w);
                *(uint2*)(o + (i >> 1) * 256 + (i & 1) * 4) = w;
            }
        } else {
            const int unit = (job - 1056) * 4 + wid;
            s5_unit<false>(P, unit & 63, unit >> 6, smem + wid * 16896);
        }
    }
}

constexpr int RW = 8208;
constexpr uint32_t PADKEY = 0x0EB60D35u;
DEV int bucket_of(float sc) { return (int)fminf(fmaxf((sc + 4.f) * 32.f, 0.f), 255.f); }
DEV float key2f(uint32_t k) { return __uint_as_float((k & 0x80000000u) ? (k ^ 0x80000000u) : ~k); }
DEV int bucket_of_key(uint32_t k) { return (k == PADKEY) ? -1 : bucket_of(key2f(k)); }
DEV uint32_t first_key_with_bucket(int bt) {
    const int lane = threadIdx.x & 63;
    uint32_t lo = PADKEY, hi = 0xFF800000u;
    while (hi - lo > 1u) {
        const uint32_t span = hi - lo, step = (span + 63u) >> 6;
        const unsigned long long off = (unsigned long long)step * (unsigned)(lane + 1);
        const uint32_t cand = (off >= span) ? hi : lo + (uint32_t)off;
        const bool pr = bucket_of_key(cand) >= bt;
        const int f = __ffsll((long long)__ballot(pr)) - 1;
        const uint32_t nhi = (uint32_t)__shfl((int)cand, f);
        const unsigned long long offl = (unsigned long long)step * (unsigned)f;
        const uint32_t nlo = (f == 0) ? lo : ((offl >= span) ? hi : lo + (uint32_t)offl);
        hi = nhi; lo = nlo;
    }
    return hi;
}
DEV uint32_t f2key(float f) { const uint32_t u = __float_as_uint(f); return u ^ ((uint32_t)((int32_t)u >> 31) | 0x80000000u); }

DEV void idx_score_tile(const bf16x8 (&a)[4], const bf16x8 (&b)[4], const float (&w)[16], float& p0, float& p1) {
    f32x16 acc;
#pragma unroll
    for (int r = 0; r < 16; ++r) acc[r] = 0.f;
#pragma unroll
    for (int ks = 0; ks < 4; ++ks) acc = __builtin_amdgcn_mfma_f32_32x32x16_bf16(a[ks], b[ks], acc, 0, 0, 0);
    p0 = 0.f; p1 = 0.f;
#pragma unroll
    for (int r = 0; r < 8; ++r) { p0 += w[r] * fmaxf(acc[r], 0.f); p1 += w[r + 8] * fmaxf(acc[r + 8], 0.f); }
    typedef unsigned u32x2_ __attribute__((ext_vector_type(2)));
    const u32x2_ sw = __builtin_amdgcn_permlane32_swap(__float_as_uint(p0), __float_as_uint(p1), false, false);
    p0 = __uint_as_float(sw[0]) + __uint_as_float(sw[1]);
    p1 = p0;
}

DEV void attn_job(const Params& P, int j, int rot, unsigned char* smem) {
    const int tid = threadIdx.x, lane = tid & 63, wid = tid >> 6;
    const int l31 = lane & 31, hl = lane >> 5;
    unsigned char* ws = P.ws;
    uint32_t* rows = (uint32_t*)smem;
    uint32_t* hist_all = (uint32_t*)(smem + 2 * RW * 4);
    const int tl0 = 2 * j, tl1 = 2 * j + 1, th0 = 8190 - 2 * j, th1 = 8191 - 2 * j;
    uint32_t* rowL0 = rows;
    uint32_t* rowH1 = rows + ((tl0 + 4) & ~3);
    uint32_t* rowL1 = rows + RW;
    uint32_t* rowH0 = rows + RW + ((tl1 + 4) & ~3);
    const int role = wid ^ ((rot & 1) << 1);
    hist_all[tid] = 0u; hist_all[tid + 256] = 0u; hist_all[tid + 512] = 0u; hist_all[tid + 768] = 0u;
    __syncthreads();
    const u16* QI = (const u16*)(ws + O_QIDX);
    const u16* KI = (const u16*)(ws + O_KIDX);
    const float* WI = (const float*)(ws + O_WIDX);
    for (int rep1 = 0; rep1 < (PROBE_SEC == 1 ? 2 : 1); ++rep1) {
        bf16x8 aL[4], aH[4];
        float wL[16], wH[16];
        {
            const int qi = l31 >> 4, head = l31 & 15;
            const u16* pl = QI + (size_t)(qi ? tl1 : tl0) * 1024 + head * 64 + 8 * hl;
            const u16* ph = QI + (size_t)(qi ? th1 : th0) * 1024 + head * 64 + 8 * hl;
#pragma unroll
            for (int ks = 0; ks < 4; ++ks) { aL[ks] = __builtin_nontemporal_load((const bf16x8*)(pl + ks * 16)); aH[ks] = __builtin_nontemporal_load((const bf16x8*)(ph + ks * 16)); }
#pragma unroll
            for (int r = 0; r < 16; ++r) {
                const int q = r >> 3, hd = (r & 3) + 8 * ((r >> 2) & 1) + 4 * hl;
                wL[r] = WI[(size_t)(q ? tl1 : tl0) * 16 + hd];
                wH[r] = WI[(size_t)(q ? th1 : th0) * 16 + hd];
            }
        }
        const int nkt = (th1 >> 5) + 1;
        bf16x8 bq[3][4];
#define KLOAD(u, ktv) { const int kc_ = min((ktv), nkt - 1); const u16* kp_ = KI + (size_t)kc_ * 2048 + hl * 256 + l31 * 8; \
            _Pragma("unroll") for (int ks = 0; ks < 4; ++ks) bq[u][ks] = *(const bf16x8*)(kp_ + ks * 512); }
        uint32_t* const rowHs = hl ? rowH1 : rowH0; const int tHs = hl ? th1 : th0; uint32_t* const hHs = hist_all + (2 + hl) * 256;
        uint32_t* const rowLs = hl ? rowL1 : rowL0; const int tLs = hl ? tl1 : tl0; uint32_t* const hLs = hist_all + hl * 256;
#define ROWPUT(rowp, hp, tq, pv) if (key < (((tq) + 4) & ~3)) { const bool ok_ = key <= (tq); rowp[key] = ok_ ? f2key(pv) : PADKEY; if (ok_) atomicAdd(&hp[bucket_of(pv)], 1u); }
#define KTILE(u, ktv) if ((ktv) < nkt) { const int key = (ktv) * 32 + l31; float p0, p1; \
            idx_score_tile(aH, bq[u], wH, p0, p1); \
            ROWPUT(rowHs, hHs, tHs, p0) \
            if ((ktv) * 32 <= tl1) { idx_score_tile(aL, bq[u], wL, p0, p1); ROWPUT(rowLs, hLs, tLs, p0) } }
        KLOAD(0, wid) KLOAD(1, wid + 4) KLOAD(2, wid + 8)
        for (int kt = wid; kt < nkt; kt += 12) {
            KTILE(0, kt) KLOAD(0, kt + 12)
            KTILE(1, kt + 4) KLOAD(1, kt + 16)
            KTILE(2, kt + 8) KLOAD(2, kt + 20)
        }
#undef KLOAD
#undef KTILE
#undef ROWPUT
    }
    __syncthreads();
    uint32_t* row; int t;
    if (role == 0) { row = rowL0; t = tl0; } else if (role == 1) { row = rowL1; t = tl1; } else if (role == 2) { row = rowH0; t = th0; } else { row = rowH1; t = th1; }
    const int n = t + 1;
    uint32_t* hrow = hist_all + role * 256;
    u16* idxl = (u16*)hrow;
    u16* cand = idxl + 256;
    int nsel;
    for (int rep2 = 0; rep2 < (PROBE_SEC == 2 ? 2 : 1); ++rep2)
    if (n <= 256) {
        nsel = n;
        LDS_FENCE();
        for (int i = lane; i < 256; i += 64) idxl[i] = (u16)((i < n) ? i : 0);
    } else {
        nsel = 256;
        int b0; uint32_t kkb, cntb;
        {
            const uint32_t c0 = hrow[255 - 4 * lane], c1 = hrow[254 - 4 * lane], c2 = hrow[253 - 4 * lane], c3 = hrow[252 - 4 * lane];
            const uint32_t sm = c0 + c1 + c2 + c3;
            uint32_t incl = sm;
#pragma unroll
            for (int d = 1; d < 64; d <<= 1) { const uint32_t v = __shfl_up(incl, d); if (lane >= d) incl += v; }
            uint32_t e = incl - sm;
            const bool hit = (e < 256u) && (256u <= incl);
            const int srcl = __ffsll((long long)__ballot(hit)) - 1;
            int bin; uint32_t nk, cb;
            if (e + c0 >= 256u) { bin = 255 - 4 * lane; nk = 256u - e; cb = c0; }
            else { e += c0; if (e + c1 >= 256u) { bin = 254 - 4 * lane; nk = 256u - e; cb = c1; }
            else { e += c1; if (e + c2 >= 256u) { bin = 253 - 4 * lane; nk = 256u - e; cb = c2; }
            else { e += c2; bin = 252 - 4 * lane; nk = 256u - e; cb = c3; } } }
            b0 = __shfl(bin, srcl); kkb = __shfl(nk, srcl); cntb = __shfl(cb, srcl);
        }
        LDS_FENCE();
        if (cntb <= 256u) {
            const int n4 = (n + 3) & ~3;
            const int ngt = 256 - (int)kkb;
            const uint32_t khi = (b0 >= 255) ? 0xFFFFFFFFu : first_key_with_bucket(b0 + 1);
            const uint32_t klo = (b0 <= 0) ? (PADKEY + 1u) : first_key_with_bucket(b0);
            uint32_t cg = 0, ce = 0;
            for (int i4 = lane * 4; i4 < n4; i4 += 256) {
                const uint4 k4 = *(const uint4*)(row + i4);
                cg += (k4.x >= khi) + (k4.y >= khi) + (k4.z >= khi) + (k4.w >= khi);
                ce += (k4.x >= klo) + (k4.y >= klo) + (k4.z >= klo) + (k4.w >= klo);
            }
            ce -= cg;
            uint32_t ig = cg, ie = ce;
#pragma unroll
            for (int d = 1; d < 64; d <<= 1) {
                const uint32_t vg = __shfl_up(ig, d), ve = __shfl_up(ie, d);
                if (lane >= d) { ig += vg; ie += ve; }
            }
            uint32_t bg = ig - cg, be = ie - ce;
            for (int i4 = lane * 4; i4 < n4; i4 += 256) {
                const uint4 k4 = *(const uint4*)(row + i4);
                const uint32_t kv[4] = {k4.x, k4.y, k4.z, k4.w};
#pragma unroll
                for (int e = 0; e < 4; ++e) {
                    if (kv[e] >= khi) { idxl[bg] = (u16)(i4 + e); ++bg; }
                    else if (kv[e] >= klo) { cand[be] = (u16)(i4 + e); ++be; }
                }
            }
            LDS_FENCE();
            uint32_t ck[4]; int ci[4];
#pragma unroll
            for (int c = 0; c < 4; ++c) { const int q = lane + 64 * c; ci[c] = (q < (int)cntb) ? (int)cand[q] : 0; }
#pragma unroll
            for (int c = 0; c < 4; ++c) ck[c] = row[ci[c]];
            LDS_FENCE();
#pragma unroll
            for (int c = 0; c < 4; ++c) { const int q = lane + 64 * c; if (q < (int)cntb) row[q] = ck[c]; }
            LDS_FENCE();
            uint32_t rk[4] = {0u, 0u, 0u, 0u};
            for (int jq = 0; jq < (int)cntb; ++jq) {
                const uint32_t kj = row[jq];
#pragma unroll
                for (int c = 0; c < 4; ++c) rk[c] += ((kj > ck[c]) || (kj == ck[c] && jq < lane + 64 * c)) ? 1u : 0u;
            }
#pragma unroll
            for (int c = 0; c < 4; ++c) { const int q = lane + 64 * c; if (q < (int)cntb && rk[c] < kkb) idxl[ngt + rk[c]] = (u16)ci[c]; }
        } else {
        uint32_t prefix = 0, kk = 256;
        for (int pass = 0; pass < 4; ++pass) {
            const int shift = 24 - 8 * pass;
            hrow[lane] = 0; hrow[lane + 64] = 0; hrow[lane + 128] = 0; hrow[lane + 192] = 0;
            LDS_FENCE();
            const int n4 = (n + 3) & ~3;
            if (pass == 0) {
                for (int i4 = lane * 4; i4 < n4; i4 += 256) {
                    const uint4 k4 = *(const uint4*)(row + i4);
                    atomicAdd(&hrow[k4.x >> 24], 1u); atomicAdd(&hrow[k4.y >> 24], 1u); atomicAdd(&hrow[k4.z >> 24], 1u); atomicAdd(&hrow[k4.w >> 24], 1u);
                }
            } else {
                const int sh8 = shift + 8;
                for (int i4 = lane * 4; i4 < n4; i4 += 256) {
                    const uint4 k4 = *(const uint4*)(row + i4);
                    if ((k4.x >> sh8) == prefix) atomicAdd(&hrow[(k4.x >> shift) & 255u], 1u);
                    if ((k4.y >> sh8) == prefix) atomicAdd(&hrow[(k4.y >> shift) & 255u], 1u);
                    if ((k4.z >> sh8) == prefix) atomicAdd(&hrow[(k4.z >> shift) & 255u], 1u);
                    if ((k4.w >> sh8) == prefix) atomicAdd(&hrow[(k4.w >> shift) & 255u], 1u);
                }
            }
            LDS_FENCE();
            const uint32_t c0 = hrow[255 - 4 * lane], c1 = hrow[254 - 4 * lane], c2 = hrow[253 - 4 * lane], c3 = hrow[252 - 4 * lane];
            const uint32_t s = c0 + c1 + c2 + c3;
            uint32_t incl = s;
#pragma unroll
            for (int d = 1; d < 64; d <<= 1) { const uint32_t v = __shfl_up(incl, d); if (lane >= d) incl += v; }
            uint32_t e = incl - s;
            const bool hit = (e < kk) && (kk <= incl);
            const unsigned long long bm = __ballot(hit);
            const int srcl = __ffsll((long long)bm) - 1;
            int bin; uint32_t nk;
            if (e + c0 >= kk) { bin = 255 - 4 * lane; nk = kk - e; }
            else { e += c0; if (e + c1 >= kk) { bin = 254 - 4 * lane; nk = kk - e; }
            else { e += c1; if (e + c2 >= kk) { bin = 253 - 4 * lane; nk = kk - e; }
            else { e += c2; bin = 252 - 4 * lane; nk = kk - e; } } }
            bin = __shfl(bin, srcl);
            nk = __shfl(nk, srcl);
            prefix = (prefix << 8) | (uint32_t)bin;
            kk = nk;
            LDS_FENCE();
        }
        const uint32_t T = prefix;
        const int ngt = 256 - (int)kk;
        const int n4 = (n + 3) & ~3;
        uint32_t cg = 0, ce = 0;
        for (int i4 = lane * 4; i4 < n4; i4 += 256) {
            const uint4 k4 = *(const uint4*)(row + i4);
            cg += (k4.x > T) + (k4.y > T) + (k4.z > T) + (k4.w > T);
            ce += (k4.x == T) + (k4.y == T) + (k4.z == T) + (k4.w == T);
        }
        uint32_t ig = cg, ie = ce;
#pragma unroll
        for (int d = 1; d < 64; d <<= 1) {
            const uint32_t vg = __shfl_up(ig, d), ve = __shfl_up(ie, d);
            if (lane >= d) { ig += vg; ie += ve; }
        }
        uint32_t bg = ig - cg, be = ie - ce;
        for (int i4 = lane * 4; i4 < n4; i4 += 256) {
            const uint4 k4 = *(const uint4*)(row + i4);
            const uint32_t kv[4] = {k4.x, k4.y, k4.z, k4.w};
#pragma unroll
            for (int e = 0; e < 4; ++e) {
                if (kv[e] > T) { idxl[bg] = (u16)(i4 + e); ++bg; }
                else if (kv[e] == T) { if (be < kk) idxl[ngt + be] = (u16)(i4 + e); ++be; }
            }
        }
        }
    }
    __syncthreads();
    float* lg = (float*)(smem + ((role == 0 || role == 3) ? 0 : RW * 4) + ((role >= 2) ? (RW * 2) : 0));
    const u16* Qp = (const u16*)(ws + O_Q) + (size_t)t * 1024;
    const u16* Kb = (const u16*)(ws + O_K);
    const u16* Vb = (const u16*)(ws + O_V);
    const int l15 = lane & 15, q4 = lane >> 4;
    const float scale = 0.08838834764831845f;
    unsigned char* scr = (unsigned char*)lg;
    for (int rep3 = 0; rep3 < (PROBE_SEC == 3 ? 2 : 1); ++rep3) {
    {
        unsigned char* ktile = scr + 8192;
        unsigned kwofs[8], krd[2][4];
#pragma unroll
        for (int i = 0; i < 8; ++i) { const unsigned row = q4 + 4 * i, ch = l15; kwofs[i] = 256u * row + 16u * (ch ^ (((row & 3) << 2) | ((row >> 2) & 3))); }
#pragma unroll
        for (int rb = 0; rb < 2; ++rb)
#pragma unroll
            for (int sx = 0; sx < 4; ++sx) { const unsigned row = l15 + 16 * rb, ch = 4 * sx + q4; krd[rb][sx] = 256u * row + 16u * (ch ^ (((row & 3) << 2) | ((row >> 2) & 3))); }
        uint4 kr0, kr1, kr2, kr3, kr4, kr5, kr6, kr7;
#define KLD1(i, dst) { const int key = idxl[ck_ * 32 + q4 + 4 * (i)]; dst = *(const uint4*)(Kb + (size_t)key * 256 + g_ * 128 + l15 * 8); }
#define KGLOAD(it_) { const int g_ = (it_) >> 3, ck_ = (it_) & 7; KLD1(0, kr0) KLD1(1, kr1) KLD1(2, kr2) KLD1(3, kr3) KLD1(4, kr4) KLD1(5, kr5) KLD1(6, kr6) KLD1(7, kr7) }
        KGLOAD(0)
#pragma unroll 1
        for (int g = 0; g < 2; ++g) {
            bf16x8 qa[4];
#pragma unroll
            for (int ks = 0; ks < 4; ++ks) {
                bf16x8 z = {0, 0, 0, 0, 0, 0, 0, 0};
                qa[ks] = z;
                if (l15 < 4) qa[ks] = __builtin_nontemporal_load((const bf16x8*)(Qp + (g * 4 + l15) * 128 + ks * 32 + 8 * q4));
            }
#pragma unroll 1
            for (int ck = 0; ck < 8; ++ck) {
                const int it = g * 8 + ck;
                *(uint4*)(ktile + kwofs[0]) = kr0; *(uint4*)(ktile + kwofs[1]) = kr1; *(uint4*)(ktile + kwofs[2]) = kr2; *(uint4*)(ktile + kwofs[3]) = kr3;
                *(uint4*)(ktile + kwofs[4]) = kr4; *(uint4*)(ktile + kwofs[5]) = kr5; *(uint4*)(ktile + kwofs[6]) = kr6; *(uint4*)(ktile + kwofs[7]) = kr7;
                if (it + 1 < 16) KGLOAD(it + 1)
                LDS_FENCE();
#pragma unroll
                for (int rb = 0; rb < 2; ++rb) {
                    f32x4 acc = {0.f, 0.f, 0.f, 0.f};
#pragma unroll
                    for (int sx = 0; sx < 4; ++sx) {
                        const bf16x8 kb = *(const bf16x8*)(ktile + krd[rb][sx]);
                        acc = __builtin_amdgcn_mfma_f32_16x16x32_bf16(qa[sx], kb, acc, 0, 0, 0);
                    }
                    if (lane < 16) {
                        const int kidx = ck * 32 + rb * 16 + lane;
                        const bool ok = kidx < nsel;
#pragma unroll
                        for (int r = 0; r < 4; ++r) lg[(g * 4 + r) * 256 + kidx] = ok ? acc[r] * scale : -INFINITY;
                    }
                }
                LDS_FENCE();
            }
        }
#undef KGLOAD
#undef KLD1
    }
    LDS_FENCE();
    {
        uint2 pk[8];
#pragma unroll
        for (int hh = 0; hh < 8; ++hh) {
            const float4 x = *(const float4*)(lg + hh * 256 + 4 * lane);
            float m = wave_max_fast(fmaxf(fmaxf(x.x, x.y), fmaxf(x.z, x.w)));
            const float e0 = __expf(x.x - m), e1 = __expf(x.y - m), e2 = __expf(x.z - m), e3 = __expf(x.w - m);
            const float inv = 1.f / wave_sum_fast(e0 + e1 + e2 + e3);
            pk[hh].x = pack2(e0 * inv, e1 * inv);
            pk[hh].y = pack2(e2 * inv, e3 * inv);
        }
        LDS_FENCE();
#pragma unroll
        for (int hh = 0; hh < 8; ++hh) *(uint2*)(scr + hh * 512 + lane * 8) = pk[hh];
    }
    }
    LDS_FENCE();
    for (int rep4 = 0; rep4 < (PROBE_SEC == 4 ? 2 : 1); ++rep4) {
        unsigned char* vt = scr + 8192;
        const int q = l15 >> 2, p = l15 & 3;
        unsigned tra[8][2];
#pragma unroll
        for (int c = 0; c < 8; ++c)
#pragma unroll
            for (int tt = 0; tt < 2; ++tt) {
                const unsigned row = 8 * q4 + 4 * tt + q, ch = 2 * c + (p >> 1);
                tra[c][tt] = 256u * row + 16u * (ch ^ (((row & 3) << 2) | ((row >> 2) & 3))) + 8 * (p & 1);
            }
        unsigned wofs[8];
#pragma unroll
        for (int i = 0; i < 8; ++i) {
            const unsigned row = q4 + 4 * i, ch = l15;
            wofs[i] = 256u * row + 16u * (ch ^ (((row & 3) << 2) | ((row >> 2) & 3)));
        }
        uint4 vr0, vr1, vr2, vr3, vr4, vr5, vr6, vr7;
#define VLD1(i, dst) { const int key = idxl[ck_ * 32 + q4 + 4 * (i)]; dst = *(const uint4*)(Vb + (size_t)key * 256 + g_ * 128 + l15 * 8); }
#define VLOAD(it_) { const int g_ = (it_) >> 3, ck_ = (it_) & 7; VLD1(0, vr0) VLD1(1, vr1) VLD1(2, vr2) VLD1(3, vr3) VLD1(4, vr4) VLD1(5, vr5) VLD1(6, vr6) VLD1(7, vr7) }
        VLOAD(0)
        const u16* za = (const u16*)(ws + O_ZA) + (size_t)t * 1024;
        u16* ya = (u16*)(ws + O_YATT) + (size_t)t * 1024;
#pragma unroll 1
        for (int g = 0; g < 2; ++g) {
            f32x4 oacc[8];
#pragma unroll
            for (int c = 0; c < 8; ++c) { f32x4 z = {0.f, 0.f, 0.f, 0.f}; oacc[c] = z; }
#pragma unroll 1
            for (int ck = 0; ck < 8; ++ck) {
                const int it = g * 8 + ck;
                *(uint4*)(vt + wofs[0]) = vr0; *(uint4*)(vt + wofs[1]) = vr1; *(uint4*)(vt + wofs[2]) = vr2; *(uint4*)(vt + wofs[3]) = vr3;
                *(uint4*)(vt + wofs[4]) = vr4; *(uint4*)(vt + wofs[5]) = vr5; *(uint4*)(vt + wofs[6]) = vr6; *(uint4*)(vt + wofs[7]) = vr7;
                if (it + 1 < 16) VLOAD(it + 1)
                LDS_FENCE();
                const bf16x8 pa = *(const bf16x8*)(scr + (g * 4 + l15) * 512 + (ck * 32 + 8 * q4) * 2);
#pragma unroll
                for (int c = 0; c < 8; ++c) {
                    typedef short s16x4 __attribute__((ext_vector_type(4)));
                    const s16x4 lo = __builtin_amdgcn_ds_read_tr16_b64_v4i16((__attribute__((address_space(3))) s16x4*)(vt + tra[c][0]));
                    const s16x4 hi = __builtin_amdgcn_ds_read_tr16_b64_v4i16((__attribute__((address_space(3))) s16x4*)(vt + tra[c][1]));
                    const bf16x8 vb = {lo[0], lo[1], lo[2], lo[3], hi[0], hi[1], hi[2], hi[3]};
                    oacc[c] = __builtin_amdgcn_mfma_f32_16x16x32_bf16(pa, vb, oacc[c], 0, 0, 0);
                }
                LDS_FENCE();
            }
            if (lane < 16) {
#pragma unroll
                for (int c = 0; c < 8; ++c)
#pragma unroll
                    for (int r = 0; r < 4; ++r) {
                        const int cb = (g * 4 + r) * 128 + c * 16 + lane;
                        __builtin_nontemporal_store(f2bf(oacc[c][r] * bf2f(__builtin_nontemporal_load(za + cb))), ya + cb);
                    }
            }
        }
#undef VLOAD
#undef VLD1
    }
    __syncthreads();
}

DEV void phaseD(const Params& P, unsigned char* smem) {
    const int wid = threadIdx.x >> 6;
    const int G = gridDim.x;
    const bool s5_last = (blockIdx.x >> 3) & 1;
    if (!s5_last) {
        for (int job = blockIdx.x; job < 512; job += G) {
            const int unit = job * 4 + wid;
            for (int rep5 = 0; rep5 < (PROBE_SEC == 5 ? 2 : 1); ++rep5) s5_unit<true>(P, unit & 63, unit >> 6, smem + wid * 16896);
            __syncthreads();
        }
    }
    for (int aj = blockIdx.x; aj < 2048; aj += G) attn_job(P, aj, aj / G, smem);
    if (s5_last) {
        for (int job = blockIdx.x; job < 512; job += G) {
            const int unit = job * 4 + wid;
            s5_unit<true>(P, unit & 63, unit >> 6, smem + wid * 16896);
            __syncthreads();
        }
    }
}

DEV void phaseE(const Params& P, unsigned char* smem) {
    ACC_IDS
    unsigned char* ws = P.ws;
    for (int job = blockIdx.x; job < 1024; job += gridDim.x) {
        const int mt = job & 63, nt = job >> 6, m0 = mt * 128;
        f32x16 acc[2][2];
        ZERO_ACC(acc);
        gemm_mainloop((const u16*)(ws + O_YACT) + (size_t)m0 * 1024, 1024, (const u16*)(ws + O_WGLU) + (size_t)nt * 128 * 1024, 1024, 1024, smem, acc);
        const u16* zs = (const u16*)(ws + O_ZS);
        u16* ys = (u16*)(ws + O_U);
        float* st = (float*)smem;
        uint4 zpre[2][2];
#pragma unroll
        for (int mi = 0; mi < 2; ++mi)
#pragma unroll
            for (int i = 0; i < 2; ++i) {
                const int cid = threadIdx.x + 256 * i, sr = cid >> 3, ac = cid & 7;
                zpre[mi][i] = ld_nt16(zs + (size_t)(m0 + SR_TO_ROW(sr, mi)) * 1024 + nt * 64 + (ac >> 2) * 32 + (ac & 3) * 8);
            }
#pragma unroll
        for (int mi = 0; mi < 2; ++mi) {
            stage_half(acc, mi, st);
#pragma unroll
            for (int i = 0; i < 2; ++i) {
                const int cid = threadIdx.x + 256 * i;
                const int sr = cid >> 3, ac = cid & 7;
                const int tcol = (ac >> 2) * 64 + (ac & 3) * 8;
                const int row = m0 + SR_TO_ROW(sr, mi);
                const int ocol = nt * 64 + (ac >> 2) * 32 + (ac & 3) * 8;
                const float4 a0 = *(const float4*)(st + sr * 132 + tcol), a1 = *(const float4*)(st + sr * 132 + tcol + 4);
                const float4 b0 = *(const float4*)(st + sr * 132 + tcol + 32), b1 = *(const float4*)(st + sr * 132 + tcol + 36);
                float z[8];
                unpack8(zpre[mi][i], z);
                float o[8];
                o[0] = a0.x * sigmoidf_(b0.x) * z[0]; o[1] = a0.y * sigmoidf_(b0.y) * z[1]; o[2] = a0.z * sigmoidf_(b0.z) * z[2]; o[3] = a0.w * sigmoidf_(b0.w) * z[3];
                o[4] = a1.x * sigmoidf_(b1.x) * z[4]; o[5] = a1.y * sigmoidf_(b1.y) * z[5]; o[6] = a1.z * sigmoidf_(b1.z) * z[6]; o[7] = a1.w * sigmoidf_(b1.w) * z[7];
                *(uint4*)(ys + (size_t)row * 1024 + ocol) = pack8(o);
            }
            __syncthreads();
        }
    }
}

DEV void phaseF(const Params& P, unsigned char* smem) {
    ACC_IDS
    unsigned char* ws = P.ws;
    const int ntile = (1024 - (int)blockIdx.x + (int)gridDim.x - 1) / (int)gridDim.x;
    uint4 part[2][4];
    for (int q = 0; q < 2 * ntile; ++q) {
        const int job = blockIdx.x + (q >> 1) * gridDim.x, pass = q & 1;
        const int mt = job & 63, nt = job >> 6, m0 = mt * 128, n0 = nt * 128;
        f32x16 acc[2][2];
        ZERO_ACC(acc);
        const u16* A = (const u16*)(ws + (pass ? O_YATT : O_U)) + (size_t)m0 * 1024;
        const u16* B = (const u16*)(ws + (pass ? O_WATTO : O_WSSMO)) + (size_t)n0 * 1024;
        gemm_mainloop(A, 1024, B, 1024, 1024, smem, acc);
        const u16* gt = (const u16*)(ws + (pass ? O_GA : O_GS));
        u16* mg = (u16*)(ws + O_MERGED);
        float* st = (float*)smem;
        uint4 gpre[2][4];
#pragma unroll
        for (int mi = 0; mi < 2; ++mi)
#pragma unroll
            for (int i_ = 0; i_ < 4; ++i_) {
                const int cid_ = threadIdx.x + 256 * i_, sr_ = cid_ >> 4, col0_ = (cid_ & 15) * 8;
                gpre[mi][i_] = ld_nt16(gt + (size_t)(m0 + SR_TO_ROW(sr_, mi)) * 2048 + n0 + col0_);
            }
#pragma unroll
        for (int mi = 0; mi < 2; ++mi) {
            stage_half(acc, mi, st);
#pragma unroll
            for (int i_ = 0; i_ < 4; ++i_) {
                CHUNK_LOAD(st)
                const size_t o = (size_t)(m0 + SR_TO_ROW(sr_, mi)) * 2048 + n0 + col0_;
                float g[8];
                unpack8(gpre[mi][i_], g);
                _Pragma("unroll") for (int e = 0; e < 8; ++e) v_[e] *= g[e];
                if (pass) {
                    float pvv[8];
                    unpack8(part[mi][i_], pvv);
                    _Pragma("unroll") for (int e = 0; e < 8; ++e) v_[e] += pvv[e];
                    *(uint4*)(mg + o) = pack8(v_);
                } else {
                    part[mi][i_] = pack8(v_);
                }
            }
            __syncthreads();
        }
    }
}

DEV void phaseG(const Params& P, unsigned char* smem) {
    ACC_IDS
    unsigned char* ws = P.ws;
    for (int job = blockIdx.x; job < 1024; job += gridDim.x) {
        const int mt = job & 63, nt = job >> 6, m0 = mt * 128, n0 = nt * 128;
        f32x16 acc[2][2];
        ZERO_ACC(acc);
        gemm_mainloop((const u16*)(ws + O_MERGED) + (size_t)m0 * 2048, 2048, (const u16*)(ws + O_WO) + (size_t)n0 * 2048, 2048, 2048, smem, acc);
        u16* xb = (u16*)(ws + O_X1B);
        float* ssq = (float*)(ws + O_SSQ1);
        float* st = (float*)smem;
#pragma unroll 1
        for (int mi = 0; mi < 2; ++mi) {
            stage_half(acc, mi, st);
            FOR_CHUNKS(st) {
                CHUNK_LOAD(st)
                const int row = m0 + SR_TO_ROW(sr_, mi);
                const size_t o = (size_t)row * 2048 + n0 + col0_;
                typedef float f32x4g_ __attribute__((ext_vector_type(4))); const f32x4g_ t0_ = __builtin_nontemporal_load((const f32x4g_*)(P.x + o)), t1_ = __builtin_nontemporal_load((const f32x4g_*)(P.x + o + 4));
                const float4 x0 = make_float4(t0_[0], t0_[1], t0_[2], t0_[3]), x1 = make_float4(t1_[0], t1_[1], t1_[2], t1_[3]);
                v_[0] += x0.x; v_[1] += x0.y; v_[2] += x0.z; v_[3] += x0.w; v_[4] += x1.x; v_[5] += x1.y; v_[6] += x1.z; v_[7] += x1.w;
                *(float4*)(P.out + o) = make_float4(v_[0], v_[1], v_[2], v_[3]);
                *(float4*)(P.out + o + 4) = make_float4(v_[4], v_[5], v_[6], v_[7]);
                *(uint4*)(xb + o) = pack8(v_);
                float ss = 0.f;
                _Pragma("unroll") for (int e = 0; e < 8; ++e) ss += v_[e] * v_[e];
                ss += __shfl_xor(ss, 1); ss += __shfl_xor(ss, 2); ss += __shfl_xor(ss, 4); ss += __shfl_xor(ss, 8);
                if ((threadIdx.x & 15) == 0) ssq[(size_t)row * 16 + nt] = ss;
            }
            __syncthreads();
        }
    }
}

DEV void phaseH(const Params& P, unsigned char* smem) {
    ACC_IDS
    const int tid = threadIdx.x;
    unsigned char* ws = P.ws;
    float* rinv_s = (float*)(smem + 65536);
    for (int job = blockIdx.x; job < 2048; job += gridDim.x) {
        const int jj = job & 1023;
        const int mt = jj & 63, nt = jj >> 6, m0 = mt * 128, n0 = nt * 128;
        f32x16 acc[2][2];
        ZERO_ACC(acc);
        if (job < 1024) {
            {
                const int row = tid >> 1, half = tid & 1;
                const float4* sp = (const float4*)((const float*)(ws + O_SSQ1) + (size_t)(m0 + row) * 16 + half * 8);
                float ss = 0.f;
#pragma unroll
                for (int i = 0; i < 2; ++i) { const float4 q = sp[i]; ss += q.x + q.y + q.z + q.w; }
                ss += __shfl_xor(ss, 1);
                if (half == 0) rinv_s[row] = rsqrtf(ss * (1.f / 2048.f) + 1e-6f);
            }
            gemm_mainloop((const u16*)(ws + O_X1B) + (size_t)m0 * 2048, 2048, (const u16*)(ws + O_WPG) + (size_t)n0 * 2048, 2048, 2048, smem, acc);
            u16* gt = (u16*)(ws + O_GS);
            float* st = (float*)smem;
#pragma unroll 1
            for (int mi = 0; mi < 2; ++mi) {
                stage_half(acc, mi, st);
                FOR_CHUNKS(st) {
                    CHUNK_LOAD(st)
                    const int rl = SR_TO_ROW(sr_, mi);
                    const float ri = rinv_s[rl];
                    _Pragma("unroll") for (int e = 0; e < 8; ++e) v_[e] = sigmoidf_(v_[e] * ri);
                    *(uint4*)(gt + (size_t)(m0 + rl) * 2048 + n0 + col0_) = pack8(v_);
                }
                __syncthreads();
            }
        } else {
            gemm_mainloop((const u16*)(ws + O_PBF) + (size_t)m0 * 256, 256, (const u16*)(ws + O_WPLE) + (size_t)n0 * 256, 256, 256, smem, acc);
            u16* er = (u16*)(ws + O_GA);
            float* ssq = (float*)(ws + O_SSQE);
            float* st = (float*)smem;
#pragma unroll 1
            for (int mi = 0; mi < 2; ++mi) {
                stage_half(acc, mi, st);
                FOR_CHUNKS(st) {
                    CHUNK_LOAD(st)
                    const int row = m0 + SR_TO_ROW(sr_, mi);
                    *(uint4*)(er + (size_t)row * 2048 + n0 + col0_) = pack8(v_);
                    float ss = 0.f;
                    _Pragma("unroll") for (int e = 0; e < 8; ++e) ss += v_[e] * v_[e];
                    ss += __shfl_xor(ss, 1); ss += __shfl_xor(ss, 2); ss += __shfl_xor(ss, 4); ss += __shfl_xor(ss, 8);
                    if ((threadIdx.x & 15) == 0) ssq[(size_t)row * 16 + nt] = ss;
                }
                __syncthreads();
            }
        }
    }
}

DEV void phaseI(const Params& P, unsigned char* smem) {
    const int tid = threadIdx.x, lane = tid & 63, wid = tid >> 6;
    unsigned char* ws = P.ws;
    for (int job = blockIdx.x; job < 2048; job += gridDim.x) {
        const int row = job * 4 + wid;
        float sse = (lane < 16) ? ((const float*)(ws + O_SSQE))[(size_t)row * 16 + lane] : 0.f;
        sse = wave_sum(sse);
        const float rinv_e = rsqrtf(sse * (1.f / 2048.f) + 1e-6f);
        float4* xo = (float4*)(P.out + (size_t)row * 2048);
        const uint2* gt = (const uint2*)((const u16*)(ws + O_GS) + (size_t)row * 2048);
        const uint2* er = (const uint2*)((const u16*)(ws + O_GA) + (size_t)row * 2048);
        const float4* gp = (const float4*)P.g_ple_post;
        const float4* gf = (const float4*)P.g_final;
        float4 v[8];
        float ss = 0.f;
#pragma unroll
        for (int i = 0; i < 8; ++i) {
            const int c = lane + 64 * i;
            const float4 x1 = xo[c];
            typedef unsigned u32x2i_ __attribute__((ext_vector_type(2))); const u32x2i_ g2v_ = __builtin_nontemporal_load((const u32x2i_*)(gt + c)), e2v_ = __builtin_nontemporal_load((const u32x2i_*)(er + c));
            uint2 g2, e2; g2.x = g2v_[0]; g2.y = g2v_[1]; e2.x = e2v_[0]; e2.y = e2v_[1];
            const float4 gg = gp[c];
            float4 o;
            o.x = x1.x + __uint_as_float(g2.x << 16) * (__uint_as_float(e2.x << 16) * rinv_e * gg.x);
            o.y = x1.y + __uint_as_float(g2.x & 0xFFFF0000u) * (__uint_as_float(e2.x & 0xFFFF0000u) * rinv_e * gg.y);
            o.z = x1.z + __uint_as_float(g2.y << 16) * (__uint_as_float(e2.y << 16) * rinv_e * gg.z);
            o.w = x1.w + __uint_as_float(g2.y & 0xFFFF0000u) * (__uint_as_float(e2.y & 0xFFFF0000u) * rinv_e * gg.w);
            v[i] = o;
            ss += o.x * o.x + o.y * o.y + o.z * o.z + o.w * o.w;
        }
        ss = wave_sum(ss);
        const float rinv = rsqrtf(ss * (1.f / 2048.f) + 1e-6f);
#pragma unroll
        for (int i = 0; i < 8; ++i) {
            const int c = lane + 64 * i;
            const float4 g = gf[c];
            xo[c] = make_float4(v[i].x * rinv * g.x, v[i].y * rinv * g.y, v[i].z * rinv * g.z, v[i].w * rinv * g.w);
        }
    }
}

#define XB_TMO      128
#define XB_XCNT(j)  (256  + 64 * (j))
#define XB_XSUB(j)  (1280 + 64 * (j))
#define XB_XGEN(j)  (2304 + 64 * (j))
#define XB_TOP      3328
#define XB_TOPGEN   3392
#define XCD_BAR_WORDS 3456
#define XB_SPIN_CAP (1u << 18)
#define LAS __attribute__((address_space(3)))

__device__ __forceinline__ unsigned xb_ld(unsigned* p)              { return __hip_atomic_load(p, __ATOMIC_RELAXED, __HIP_MEMORY_SCOPE_AGENT); }
__device__ __forceinline__ unsigned xb_add(unsigned* p, unsigned v) { return __hip_atomic_fetch_add(p, v, __ATOMIC_RELAXED, __HIP_MEMORY_SCOPE_AGENT); }
__device__ __forceinline__ unsigned xb_xcc_id() { return (unsigned)__builtin_amdgcn_s_getreg((3 << 11) | 20) & 0xFu; }
#define XB_SPIN(cond, bar) do { unsigned _sp = 0; while (cond) { __builtin_amdgcn_s_sleep(1); \
    if ((++_sp & 255u) == 0u) { if (xb_ld(&(bar)[XB_TMO])) break; if (_sp > XB_SPIN_CAP) { atomicAdd(&(bar)[XB_TMO], 1u); break; } } } } while (0)

struct XcdBarrier {
    unsigned* bar; unsigned x;
    volatile LAS unsigned* st;
};

__device__ __forceinline__ XcdBarrier xcd_barrier_post(unsigned* bar, volatile LAS unsigned* st) {
    XcdBarrier b; b.bar = bar; b.x = xb_xcc_id(); b.st = st;
    if (threadIdx.x == 0) (void)xb_add(&bar[XB_XCNT(b.x)], 1u);
    return b;
}
__device__ __forceinline__ void xcd_barrier_complete(unsigned* bar, unsigned x, unsigned& nloc, unsigned& nx) {
    const unsigned G = gridDim.x * gridDim.y * gridDim.z;
    unsigned sum, cnt, mine, sp = 0u;
    for (;;) {
        sum = 0u; cnt = 0u; mine = 0u;
#pragma unroll
        for (unsigned j = 0; j < 16; ++j) { const unsigned c = xb_ld(&bar[XB_XCNT(j)]); sum += c; cnt += (c > 0u) ? 1u : 0u; mine = (j == x) ? c : mine; }
        if (sum == G) break;
        __builtin_amdgcn_s_sleep(1);
        if ((++sp & 255u) == 0u) { if (xb_ld(&bar[XB_TMO])) break; if (sp > XB_SPIN_CAP) { atomicAdd(&bar[XB_TMO], 1u); break; } }
    }
    nloc = mine > 0u ? mine : 1u; nx = cnt > 0u ? cnt : 1u;
}

__device__ __forceinline__ void xcd_barrier(const XcdBarrier& b) {
    asm volatile("s_waitcnt vmcnt(0)" ::: "memory");
    __syncthreads();
    if (threadIdx.x == 0) {
        unsigned* bar = b.bar;
        __builtin_amdgcn_s_waitcnt(0);
        unsigned nloc = b.st[0], nx = b.st[1];
        if (nloc == 0u) { xcd_barrier_complete(bar, b.x, nloc, nx); b.st[0] = nloc; b.st[1] = nx; }
        const unsigned old = xb_add(&bar[XB_XSUB(b.x)], 1u);
        const unsigned gen = old / nloc;
        if (old + 1u == (gen + 1u) * nloc) {
            __builtin_amdgcn_fence(__ATOMIC_RELEASE, "agent");
            asm volatile("s_waitcnt vmcnt(0)" ::: "memory");
            const unsigned og = xb_add(&bar[XB_TOP], 1u);
            const unsigned tg = og / nx;
            if (og + 1u == (tg + 1u) * nx) xb_add(&bar[XB_TOPGEN], 1u);
            else XB_SPIN(xb_ld(&bar[XB_TOPGEN]) == tg, bar);
            __builtin_amdgcn_fence(__ATOMIC_ACQUIRE, "agent");
            xb_add(&bar[XB_XGEN(b.x)], 1u);
            asm volatile("s_waitcnt vmcnt(0)" ::: "memory");
        } else {
            XB_SPIN(xb_ld(&bar[XB_XGEN(b.x)]) == gen, bar);
            __builtin_amdgcn_fence(__ATOMIC_ACQUIRE, "agent");
            asm volatile("s_waitcnt vmcnt(0)" ::: "memory");
        }
    }
    __syncthreads();
}


__global__ void __launch_bounds__(256, 2) mega(Params P) {
    extern __shared__ __align__(16) unsigned char smem[];
    cg::grid_group grid = cg::this_grid();
    const int lo = P.ph_lo, hi = P.ph_hi;
    volatile LAS unsigned* xst = (volatile LAS unsigned*)(smem + LDS_BYTES - 16);
    if (threadIdx.x == 0) { xst[0] = 0u; xst[1] = 0u; }
    __syncthreads();
    const XcdBarrier xb = xcd_barrier_post((unsigned*)(P.ws + O_BAR), xst);
    if (lo < 0) grid.sync();
    if (lo <= 0 && 0 < hi) phaseA(P, smem);
#if PROBE_DUP == 0
    xcd_barrier(xb); phaseA(P, smem);
#endif
    if (lo < 1 && 1 < hi) xcd_barrier(xb);
    if (lo <= 1 && 1 < hi) phaseB(P, smem);
#if PROBE_DUP == 1
    xcd_barrier(xb); phaseB(P, smem);
#endif
    if (lo < 2 && 2 < hi) xcd_barrier(xb);
    if (lo <= 2 && 2 < hi) phaseC(P, smem);
#if PROBE_DUP == 2
    xcd_barrier(xb); phaseC(P, smem);
#endif
    if (lo < 3 && 3 < hi) xcd_barrier(xb);
    if (lo <= 3 && 3 < hi) phaseD(P, smem);
#if PROBE_DUP == 3
    xcd_barrier(xb); phaseD(P, smem);
#endif
    if (lo < 4 && 4 < hi) xcd_barrier(xb);
    if (lo <= 4 && 4 < hi) phaseE(P, smem);
#if PROBE_DUP == 4
    xcd_barrier(xb); phaseE(P, smem);
#endif
    if (lo < 5 && 5 < hi) xcd_barrier(xb);
    if (lo <= 5 && 5 < hi) phaseF(P, smem);
#if PROBE_DUP == 5
    xcd_barrier(xb); phaseF(P, smem);
#endif
    if (lo < 6 && 6 < hi) xcd_barrier(xb);
    if (lo <= 6 && 6 < hi) phaseG(P, smem);
#if PROBE_DUP == 6
    xcd_barrier(xb); phaseG(P, smem);
#endif
    if (lo < 7 && 7 < hi) xcd_barrier(xb);
    if (lo <= 7 && 7 < hi) phaseH(P, smem);
#if PROBE_DUP == 7
    xcd_barrier(xb); phaseH(P, smem);
#endif
    if (lo < 8 && 8 < hi) xcd_barrier(xb);
    if (lo <= 8 && 8 < hi) phaseI(P, smem);
}

extern "C" void kernel_launch(void* const* d_in, const int* in_sizes, int n_in, void* d_out, int out_size,
                              void* d_ws, size_t ws_size, hipStream_t stream) {
    static int grid_blocks = 0;
    if (!grid_blocks) {
        if (n_in != 25 || ws_size < WS_END) { fprintf(stderr, "kernel_launch: unexpected n_in %d / ws %zu (need %zu)\n", n_in, ws_size, (size_t)WS_END); grid_blocks = -1; return; }
        int dev = 0, cus = 0, per_cu = 0;
        hipGetDevice(&dev);
        hipDeviceGetAttribute(&cus, hipDeviceAttributeMultiprocessorCount, dev);
        hipFuncSetAttribute((const void*)mega, hipFuncAttributeMaxDynamicSharedMemorySize, LDS_BYTES);
        hipOccupancyMaxActiveBlocksPerMultiprocessor(&per_cu, (const void*)mega, 256, LDS_BYTES);
        if (per_cu < 1) per_cu = 1;
        if (per_cu > 2) per_cu = 2;
        grid_blocks = cus * per_cu;
    }
    if (grid_blocks < 0) return;
    Params p{};
    const float** f = (const float**)&p;
    for (int i = 0; i < 25; ++i) f[i] = (const float*)d_in[i];
    p.out = (float*)d_out;
    p.ws = (unsigned char*)d_ws;
    (void)hipMemsetAsync((unsigned char*)d_ws + O_BAR, 0, XCD_BAR_WORDS * sizeof(unsigned), stream);
#if N_LAUNCH_MODE == 1
    p.ph_lo = 0; p.ph_hi = NPHASE;
    void* args[] = {&p};
    hipError_t e = hipLaunchCooperativeKernel((const void*)mega, dim3(grid_blocks), dim3(256), args, LDS_BYTES, stream);
    if (e != hipSuccess) fprintf(stderr, "cooperative launch failed: %s (grid %d)\n", hipGetErrorString(e), grid_blocks);
#else
    for (int ph = 0; ph < NPHASE; ++ph) {
        p.ph_lo = ph; p.ph_hi = ph + 1;
        hipLaunchKernelGGL(mega, dim3(grid_blocks), dim3(256), LDS_BYTES, stream, p);
    }
#endif
}
```
